# Optimizing an MI355X kernel written in HIP

```python
import math
import jax
import jax.numpy as jnp
from jax import lax
import numpy as np

D_MODEL = 4096
BATCH = 8
SEQ = 2048
DEPTH = 2

GRID_W = 64
CTX_LEN = 256
N_EVEN = (DEPTH + 1) // 2
N_ODD = DEPTH // 2
EPS = 1e-6
ROPE_THETA = 10000.0
Q_BLOCK = 128

POOL_WINDOWS = (2, 4, 8, 16)
POOL_WIDTH = D_MODEL // 2
POOL_GROUP = POOL_WIDTH // len(POOL_WINDOWS)
SGU_WIDTH = D_MODEL // 2
SGU_HEADS = 4
SGU_HEAD_DIM = SGU_WIDTH // SGU_HEADS
SGU_CHUNK = 128
EVEN_IN = POOL_WIDTH + 2 * SGU_WIDTH
EVEN_OUT = POOL_WIDTH + SGU_WIDTH
MLA_HEADS = 16
MLA_Q_RANK = 1024
MLA_KV_RANK = 512
MLA_NOPE = 128
MLA_ROPE = 64
MLA_QK = MLA_NOPE + MLA_ROPE
MLA_V = 128
MLA_SCALE = 1.0 / math.sqrt(MLA_QK)
GQA_HEADS = 16
GQA_KV_HEADS = 4
GQA_HEAD_DIM = 128
GQA_SCALE = 1.0 / math.sqrt(GQA_HEAD_DIM)
ODD_Q_COLS = MLA_Q_RANK + GQA_HEADS * GQA_HEAD_DIM
KV_OFF_KR = MLA_KV_RANK
KV_OFF_GK = KV_OFF_KR + MLA_ROPE
KV_OFF_GV = KV_OFF_GK + GQA_KV_HEADS * GQA_HEAD_DIM
ODD_KV_COLS = KV_OFF_GV + GQA_KV_HEADS * GQA_HEAD_DIM
ODD_IN = ODD_Q_COLS + ODD_KV_COLS
ODD_OUT = MLA_HEADS * MLA_V + GQA_HEADS * GQA_HEAD_DIM
FFN_HIDDEN = ((8 * D_MODEL + 3 * 256 - 1) // (3 * 256)) * 256

kernel_name = "hybrid_pool_sgu_mla_gqa_dit_trunk"


def rms_norm(x, g):
    xf = x.astype(jnp.float32)
    y = xf * lax.rsqrt(jnp.mean(xf * xf, axis=-1, keepdims=True) + EPS)
    return (y * g.astype(jnp.float32)).astype(x.dtype)


def adaln(cvec, w, b):
    m = jax.nn.silu(cvec) @ w + b
    return jnp.split(m[:, None, :], 6, axis=-1)


def modulate(h, shift, scale):
    return h * (1 + scale) + shift


def axial_rope_table(rows, rot_dim):
    row = jnp.repeat(jnp.arange(rows, dtype=jnp.float32), GRID_W)
    col = jnp.tile(jnp.arange(GRID_W, dtype=jnp.float32), rows)
    n_freq = rot_dim // 4
    inv = ROPE_THETA ** (-jnp.arange(n_freq, dtype=jnp.float32) / n_freq)
    ang = jnp.concatenate([row[:, None] * inv, col[:, None] * inv], axis=-1)
    return jnp.cos(ang), jnp.sin(ang)


def apply_rope(x, cos, sin):
    x1, x2 = jnp.split(x, 2, axis=-1)
    cs = cos[None, :, None, :]
    sn = sin[None, :, None, :]
    return jnp.concatenate([x1 * cs - x2 * sn, x1 * sn + x2 * cs], axis=-1).astype(x.dtype)


def centred_pool_minus_self(h, window):
    L = h.shape[1]
    half = window // 2
    cs = jnp.pad(jnp.cumsum(h.astype(jnp.float32), axis=1), ((0, 0), (1, 0), (0, 0)))
    t = jnp.arange(L)
    lo = jnp.clip(t - half, 0, L)
    hi = jnp.clip(t - half + window, 0, L)
    cnt = (hi - lo).astype(jnp.float32)
    mean = (cs[:, hi] - cs[:, lo]) / cnt[None, :, None]
    return mean.astype(h.dtype) - h


def pool_mixer(a, pool_w, pool_scale):
    groups = jnp.split(a, len(POOL_WINDOWS), axis=-1)
    pooled = jnp.stack([centred_pool_minus_self(g, w) for g, w in zip(groups, POOL_WINDOWS)], axis=2)
    mixed = jnp.einsum('blgc,gcd->blgd', pooled, pool_w)
    return mixed.reshape(a.shape) * pool_scale


def sgu_mixer(uv, norm_g, w_s, b_s):
    B, L, _ = uv.shape
    u, v = jnp.split(jax.nn.gelu(uv), 2, axis=-1)
    v = v.reshape(B, L // SGU_CHUNK, SGU_CHUNK, SGU_HEADS, SGU_HEAD_DIM)
    v = rms_norm(v, norm_g)
    gate = jnp.einsum('hpq,bnqhd->bnphd', w_s, v) + b_s.T[None, None, :, :, None]
    return u * gate.reshape(B, L, SGU_WIDTH)


def even_mixer(h, w_in, pool_w, pool_scale, sgu_norm_g, sgu_w_s, sgu_b, w_out):
    z = h @ w_in
    ya = pool_mixer(z[..., :POOL_WIDTH], pool_w, pool_scale)
    yb = sgu_mixer(z[..., POOL_WIDTH:], sgu_norm_g, sgu_w_s, sgu_b)
    return jnp.concatenate([ya, yb], axis=-1) @ w_out


def odd_queries(zq, q_a_g, w_q_b, q_norm_g, rope):
    B, L, _ = zq.shape
    q = (rms_norm(zq[..., :MLA_Q_RANK], q_a_g) @ w_q_b).reshape(B, L, MLA_HEADS, MLA_QK)
    gq = rms_norm(zq[..., MLA_Q_RANK:].reshape(B, L, GQA_HEADS, GQA_HEAD_DIM), q_norm_g)
    if rope is not None:
        cos_m, sin_m, cos_g, sin_g = rope
        q = jnp.concatenate([q[..., :MLA_NOPE], apply_rope(q[..., MLA_NOPE:], cos_m, sin_m)], axis=-1)
        gq = apply_rope(gq, cos_g, sin_g)
    return (q, gq)


def odd_keys(zkv, kv_a_g, w_kv_b, k_norm_g, rope):
    B, L, _ = zkv.shape
    kv = (rms_norm(zkv[..., :MLA_KV_RANK], kv_a_g) @ w_kv_b).reshape(B, L, MLA_HEADS, MLA_NOPE + MLA_V)
    k_nope, v = kv[..., :MLA_NOPE], kv[..., MLA_NOPE:]
    kr = zkv[..., KV_OFF_KR:KV_OFF_GK][:, :, None, :]
    gk = rms_norm(zkv[..., KV_OFF_GK:KV_OFF_GV].reshape(B, L, GQA_KV_HEADS, GQA_HEAD_DIM), k_norm_g)
    gv = zkv[..., KV_OFF_GV:].reshape(B, L, GQA_KV_HEADS, GQA_HEAD_DIM)
    if rope is not None:
        cos_m, sin_m, cos_g, sin_g = rope
        kr = apply_rope(kr, cos_m, sin_m)
        gk = apply_rope(gk, cos_g, sin_g)
    k = jnp.concatenate([k_nope, jnp.broadcast_to(kr, (B, L, MLA_HEADS, MLA_ROPE))], axis=-1)
    return (k, v, gk, gv)


def attend(q, k, v, scale):
    B, Lq, Hq, dk = q.shape
    Hkv = k.shape[2]
    G = Hq // Hkv
    dv = v.shape[-1]

    def block(qb):
        qb = qb.reshape(B, Q_BLOCK, Hkv, G, dk)
        s = jnp.einsum('bqhgd,bkhd->bhgqk', qb, k, preferred_element_type=jnp.float32) * scale
        p = jax.nn.softmax(s, axis=-1).astype(v.dtype)
        o = jnp.einsum('bhgqk,bkhd->bqhgd', p, v)
        return o.reshape(B, Q_BLOCK, Hq, dv)

    nb = Lq // Q_BLOCK
    qb = q.reshape(B, nb, Q_BLOCK, Hq, dk).transpose(1, 0, 2, 3, 4)
    o = lax.map(block, qb)
    return o.transpose(1, 0, 2, 3, 4).reshape(B, Lq, Hq, dv)


def odd_attend(qs, kvs, w_out):
    q_m, q_g = qs
    k_m, v_m, k_g, v_g = kvs
    B, L = q_m.shape[0], q_m.shape[1]
    o_m = attend(q_m, k_m, v_m, MLA_SCALE).reshape(B, L, MLA_HEADS * MLA_V)
    o_g = attend(q_g, k_g, v_g, GQA_SCALE).reshape(B, L, GQA_HEADS * GQA_HEAD_DIM)
    return jnp.concatenate([o_m, o_g], axis=-1) @ w_out


def swiglu(h, w_gu, w_down):
    g, u = jnp.split(h @ w_gu, 2, axis=-1)
    return (jax.nn.silu(g) * u) @ w_down


def setup_inputs(seed: int = 0) -> dict:
    key = jax.random.key(seed)
    ks = jax.random.split(key, 26)

    def nrm(i, shape, std):
        return jax.random.normal(ks[i], shape, jnp.float32) * std

    def gain(i, shape):
        return 1.0 + 0.05 * jax.random.normal(ks[i], shape, jnp.float32)

    D = D_MODEL
    return {
        "x": nrm(0, (BATCH, SEQ, D), 1.0),
        "c": nrm(1, (BATCH, D), 1.0),
        "ctx": nrm(2, (BATCH, CTX_LEN, D), 1.0),
        "c_ctx": nrm(3, (D,), 1.0),
        "mod_w": nrm(4, (DEPTH, D, 6 * D), 0.5 * D ** -0.5),
        "mod_b": nrm(5, (DEPTH, 6 * D), 0.02),
        "norm1_g": gain(6, (DEPTH, D)),
        "norm2_g": gain(7, (DEPTH, D)),
        "final_g": gain(8, (D,)),
        "ffn_w_gu": nrm(9, (DEPTH, D, 2 * FFN_HIDDEN), D ** -0.5),
        "ffn_w_down": nrm(10, (DEPTH, FFN_HIDDEN, D), FFN_HIDDEN ** -0.5),
        "ev_w_in": nrm(11, (N_EVEN, D, EVEN_IN), D ** -0.5),
        "ev_pool_w": nrm(12, (N_EVEN, len(POOL_WINDOWS), POOL_GROUP, POOL_GROUP), POOL_GROUP ** -0.5),
        "ev_pool_scale": gain(13, (N_EVEN, POOL_WIDTH)),
        "ev_sgu_norm_g": gain(14, (N_EVEN, SGU_HEADS, SGU_HEAD_DIM)),
        "ev_sgu_w_s": nrm(15, (N_EVEN, SGU_HEADS, SGU_CHUNK, SGU_CHUNK), SGU_CHUNK ** -0.5),
        "ev_sgu_b": gain(16, (N_EVEN, SGU_HEADS, SGU_CHUNK)),
        "ev_w_out": nrm(17, (N_EVEN, EVEN_OUT, D), EVEN_OUT ** -0.5),
        "od_w_in": nrm(18, (N_ODD, D, ODD_IN), D ** -0.5),
        "od_q_a_g": gain(19, (N_ODD, MLA_Q_RANK)),
        "od_w_q_b": nrm(20, (N_ODD, MLA_Q_RANK, MLA_HEADS * MLA_QK), MLA_Q_RANK ** -0.5),
        "od_kv_a_g": gain(21, (N_ODD, MLA_KV_RANK)),
        "od_w_kv_b": nrm(22, (N_ODD, MLA_KV_RANK, MLA_HEADS * (MLA_NOPE + MLA_V)), MLA_KV_RANK ** -0.5),
        "od_q_norm_g": gain(23, (N_ODD, GQA_HEAD_DIM)),
        "od_k_norm_g": gain(24, (N_ODD, GQA_HEAD_DIM)),
        "od_w_out": nrm(25, (N_ODD, ODD_OUT, D), ODD_OUT ** -0.5),
    }


def reference(x, c, ctx, c_ctx, mod_w, mod_b, norm1_g, norm2_g, final_g, ffn_w_gu, ffn_w_down,
              ev_w_in, ev_pool_w, ev_pool_scale, ev_sgu_norm_g, ev_sgu_w_s, ev_sgu_b, ev_w_out,
              od_w_in, od_q_a_g, od_w_q_b, od_kv_a_g, od_w_kv_b, od_q_norm_g, od_k_norm_g, od_w_out):
    rows = x.shape[1] // GRID_W
    rope = (*axial_rope_table(rows, MLA_ROPE), *axial_rope_table(rows, GQA_HEAD_DIM))
    c_ctx_row = c_ctx[None, :]
    for i in range(DEPTH):
        last = i == DEPTH - 1
        odd = i % 2 == 1
        j = i // 2
        ctx_live = (not last) or odd
        sh1, sc1, g1, sh2, sc2, g2 = adaln(c, mod_w[i], mod_b[i])
        hx = modulate(rms_norm(x, norm1_g[i]), sh1, sc1)
        if ctx_live:
            csh1, csc1, cg1, csh2, csc2, cg2 = adaln(c_ctx_row, mod_w[i], mod_b[i])
            hc = modulate(rms_norm(ctx, norm1_g[i]), csh1, csc1)
        if not odd:
            ev = (ev_w_in[j], ev_pool_w[j], ev_pool_scale[j], ev_sgu_norm_g[j], ev_sgu_w_s[j], ev_sgu_b[j],
                  ev_w_out[j])
            x = x + g1 * even_mixer(hx, *ev)
            if not last:
                ctx = ctx + cg1 * even_mixer(hc, *ev)
        else:
            w_in = od_w_in[j]
            zx = hx @ w_in
            kv_c = odd_keys(hc @ w_in[:, ODD_Q_COLS:], od_kv_a_g[j], od_w_kv_b[j], od_k_norm_g[j], None)
            kv_x = odd_keys(zx[..., ODD_Q_COLS:], od_kv_a_g[j], od_w_kv_b[j], od_k_norm_g[j], rope)
            kv_all = [jnp.concatenate([a, b], axis=1) for a, b in zip(kv_c, kv_x)]
            q_x = odd_queries(zx[..., :ODD_Q_COLS], od_q_a_g[j], od_w_q_b[j], od_q_norm_g[j], rope)
            x = x + g1 * odd_attend(q_x, kv_all, od_w_out[j])
            if not last:
                q_c = odd_queries(hc @ w_in[:, :ODD_Q_COLS], od_q_a_g[j], od_w_q_b[j], od_q_norm_g[j], None)
                ctx = ctx + cg1 * odd_attend(q_c, kv_c, od_w_out[j])
        x = x + g2 * swiglu(modulate(rms_norm(x, norm2_g[i]), sh2, sc2), ffn_w_gu[i], ffn_w_down[i])
        if not last:
            ctx = ctx + cg2 * swiglu(modulate(rms_norm(ctx, norm2_g[i]), csh2, csc2), ffn_w_gu[i], ffn_w_down[i])
    return rms_norm(x, final_g)
```

```cpp
#include <hip/hip_runtime.h>
#include <cstdio>
#include <cstdint>

#ifndef MK_N_LAUNCHES
#define MK_N_LAUNCHES 1
#endif

#define LAS __attribute__((address_space(3)))
#define GAS __attribute__((address_space(1)))
typedef unsigned short bf16_t;
typedef short bf16x8 __attribute__((ext_vector_type(8)));
typedef short s16x4 __attribute__((ext_vector_type(4)));
typedef float f32x2 __attribute__((ext_vector_type(2)));
typedef float f32x4 __attribute__((ext_vector_type(4)));
typedef float f32x16 __attribute__((ext_vector_type(16)));
typedef unsigned u32x2 __attribute__((ext_vector_type(2)));
typedef unsigned u32x4 __attribute__((ext_vector_type(4)));

constexpr int D = 4096, NB = 8, SEQ = 2048, CTXL = 256, LT = SEQ + CTXL  , MALL = NB * LT  ;
constexpr int NPAN = MALL / 256  , NPANX = NB * SEQ / 256  ;
constexpr int MODW = 6 * D;
constexpr int FFH = 11008, FFN2 = 2 * FFH;
constexpr int EV_IN = 6144;
constexpr int ODIN = 4672, ODIN_P = 4864;
constexpr int OC_CQ = 0, OC_GQ = 1024, OC_CKV = 3072, OC_GK = 3584, OC_GV = 4096, OC_KR = 4608;
constexpr int QMW = 3072, KVW = 4096;
constexpr float EPS = 1e-6f;

constexpr size_t MiB = 1u << 20;
constexpr size_t al(size_t x) { return (x + MiB - 1) / MiB * MiB; }
constexpr size_t WS_CTL = 0, CTL_BYTES = 1 * MiB;
constexpr size_t WS_MOD = WS_CTL + CTL_BYTES;
constexpr size_t WS_ROPEM = WS_MOD + al((size_t)2 * 9 * MODW * 4);
constexpr size_t WS_ROPEG = WS_ROPEM + al((size_t)2 * 2048 * 32 * 4);
constexpr size_t WS_WEVIN = WS_ROPEG + al((size_t)2 * 2048 * 64 * 4);
constexpr size_t WS_WEVOUT = WS_WEVIN + al((size_t)EV_IN * D * 2);
constexpr size_t WS_WPOOL = WS_WEVOUT + al((size_t)D * D * 2);
constexpr size_t WS_WSGU = WS_WPOOL + al((size_t)4 * 512 * 512 * 2);
constexpr size_t WS_WGU = WS_WSGU + al((size_t)4 * 128 * 128 * 2);
constexpr size_t WGU_L = (size_t)FFN2 * D * 2;
constexpr size_t WS_WDOWN = WS_WGU + al(2 * WGU_L);
constexpr size_t WDOWN_L = (size_t)D * FFH * 2;
constexpr size_t WS_WODIN = WS_WDOWN + al(2 * WDOWN_L);
constexpr size_t WS_WQB = WS_WODIN + al((size_t)ODIN_P * D * 2);
constexpr size_t WS_WKVB = WS_WQB + al((size_t)QMW * 1024 * 2);
constexpr size_t WS_WODOUT = WS_WKVB + al((size_t)KVW * 512 * 2);
constexpr size_t WS_X = WS_WODOUT + al((size_t)D * D * 2);
constexpr size_t WS_H = WS_X + al((size_t)MALL * D * 4);
constexpr size_t WS_Z = WS_H + al((size_t)MALL * D * 2);
constexpr size_t WS_PA = WS_Z + al((size_t)MALL * EV_IN * 2);
constexpr size_t WS_YC = WS_PA + al((size_t)MALL * 2048 * 2);
constexpr size_t WS_HID = WS_YC + al((size_t)MALL * D * 2);
constexpr size_t WS_QM = WS_HID + al((size_t)MALL * FFH * 2);
constexpr size_t WS_KVM = WS_QM + al((size_t)MALL * QMW * 2);
constexpr size_t WS_XB = WS_KVM + al((size_t)MALL * KVW * 2);
constexpr size_t WS_PART = WS_XB + al((size_t)MALL * D * 2);
constexpr size_t WS_END = WS_PART + al((size_t)2 * NB * CTXL * D * 4);
constexpr int CW_BAR = 4096, CW_HDONE = 80000, CW_HSTOP = 80064;

constexpr int RING_BYTES = 131072, MISC_OFF = RING_BYTES + 320, LDS_BYTES = 147456;

__device__ __forceinline__ unsigned cvt_pk_bf16(float lo, float hi) { unsigned r; asm volatile("v_cvt_pk_bf16_f32 %0, %1, %2" : "=v"(r) : "v"(lo), "v"(hi)); return r; }
__device__ __forceinline__ float bf_lo(unsigned w) { return __uint_as_float(w << 16); }
__device__ __forceinline__ float bf_hi(unsigned w) { return __uint_as_float(w & 0xffff0000u); }
__device__ __forceinline__ float bf2f(bf16_t b) { return __uint_as_float(((unsigned)b) << 16); }
__device__ __forceinline__ bf16_t f2bf(float f) { return (bf16_t)(cvt_pk_bf16(f, 0.f) & 0xffffu); }
__device__ __forceinline__ float wave_sum(float v) {
#pragma unroll
    for (int o = 1; o < 64; o <<= 1) v += __shfl_xor(v, o);
    return v;
}
__device__ __forceinline__ int lane_id() { return (int)__builtin_amdgcn_mbcnt_hi(~0u, __builtin_amdgcn_mbcnt_lo(~0u, 0u)); }
__device__ __forceinline__ int launder_tid(int wave) { int t = wave * 64 + lane_id(); asm volatile("" : "+v"(t)); return t; }
#define LDS_WAIT() asm volatile("s_waitcnt lgkmcnt(0)" ::: "memory")
#define VM_WAIT() asm volatile("s_waitcnt vmcnt(0)" ::: "memory")
__device__ __forceinline__ int xrow(int idx) { return (idx >> 11) * LT + CTXL + (idx & 2047); }
__device__ __forceinline__ int pan_x(int pmx) { return (pmx >> 3) * 9 + 1 + (pmx & 7); }
__device__ __forceinline__ int mod_row_of_panel(int pm) { return (pm % 9 == 0) ? 8 : pm / 9; }

namespace pg8 {
constexpr int BM = 256, BK = 64, HALF = 128, HTB = HALF * BK * 2, STAGE_BYTES = 8 * HTB, NXCD = 8, WGM = 8;
__host__ __device__ __forceinline__ int lds_byte(int r, int c) { const int st = (r >> 4) * 2 + (c >> 5), rr = r & 15, cc = c & 31, ob = rr * 64 + cc * 2; return st * 1024 + (ob ^ (((ob >> 9) & 1) << 5)); }
__host__ __device__ __forceinline__ void stage_rc(int b, int& R, int& C) { const int st = b / 1024, sb = b % 1024, swz = sb ^ (((sb >> 9) & 1) << 5); R = (st >> 1) * 16 + swz / 64; C = (st & 1) * 32 + (swz % 64) / 2; }
__host__ __device__ __forceinline__ int perm32(int rho) { const int n = rho >> 4, i = rho & 15; return 8 * (i >> 2) + 4 * n + (i & 3); }

struct Unit { int pm, pn, k0t, split; };
struct Gemm { const bf16_t* A; const bf16_t* Bt; int lda, ldb, K, ashift, astride; };

template <int WGM_>
__device__ __forceinline__ void grid_unit(int wgid, int nM, int nN, int& pm, int& pn) {
    const int nwg = nM * nN;
    { const int q = nwg / NXCD, r = nwg % NXCD, xcd = wgid % NXCD, off = wgid / NXCD; wgid = (xcd < r ? xcd * (q + 1) : r * (q + 1) + (xcd - r) * q) + off; }
    const int nig = WGM_ * nN, gid = wgid / nig, fm = gid * WGM_, gsz = (nM - fm) < WGM_ ? (nM - fm) : WGM_;
    pm = fm + ((wgid % nig) % gsz); pn = (wgid % nig) / gsz;
}
struct OrderAll {
    int nN, G, c;
    __device__ __forceinline__ bool next(int i, Unit& u) const { const long L = (long)i * G + c; if (c >= G || L >= (long)NPAN * nN) return false; grid_unit<9>((int)L, NPAN, nN, u.pm, u.pn); u.k0t = 0; u.split = 0; return true; }
};
template <int WG_PAN = 8>
struct OrderX {
    int nN, G, c;
    __device__ __forceinline__ bool next(int i, Unit& u) const { const long L = (long)i * G + c; if (c >= G || L >= (long)NPANX * nN) return false; int pm; grid_unit<WG_PAN>((int)L, NPANX, nN, pm, u.pn); u.pm = pan_x(pm); u.k0t = 0; u.split = 0; return true; }
};
template <int WG_PAN = 8>
struct OrderXSplitCtx {
    int G, c, ntk;
    __device__ __forceinline__ bool next(int i, Unit& u) const { const int L = i * G + c;
        if (L < NPANX * 16) { int pm; grid_unit<WG_PAN>(L, NPANX, 16, pm, u.pn); u.pm = pan_x(pm); u.k0t = 0; u.split = 0; return true; }
        const int l2 = L - NPANX * 16; if (l2 >= 256) return false; const int tile = l2 >> 1; u.pm = (tile >> 4) * 9; u.pn = tile & 15; u.k0t = (l2 & 1) * (ntk >> 1); u.split = 1 + (l2 & 1); return true; }
};
struct OrderOdIn {
    int G, c;
    __device__ __forceinline__ bool next(int i, Unit& u) const { const int L = i * G + c; constexpr int NXU = NPANX * 19; u.k0t = 0; u.split = 0;
        if (L < NXU) { int pm; grid_unit<8>(L, NPANX, 19, pm, u.pn); u.pm = pan_x(pm); return true; }
        const int l2 = L - NXU; if (l2 >= 8 * 7) return false; u.pm = (l2 & 7) * 9; u.pn = 12 + (l2 >> 3); return true; }
};

template <class Epi, class Sched>
__device__ __forceinline__ void gemm_phase(LAS unsigned char* lds, const Gemm g, const Sched& S, const Epi& E, const int wave) {
    const int tid = launder_tid(wave), wid = wave, lane = tid & 63, wr = wid >> 2, wc = wid & 3, fr = lane & 15, fq = lane >> 4;
    const int K = g.K, nt = K / BK;
    unsigned voffA[2], voffB[2];
#pragma unroll
    for (int i = 0; i < 2; ++i) { int R, C; stage_rc(tid * 16 + i * 8192, R, C); const int Rb = Epi::PERM ? ((R & ~31) + perm32(R & 31)) : R;
        voffA[i] = (unsigned)(R * g.lda + C) * 2u; voffB[i] = (unsigned)(Rb * g.ldb + C) * 2u; }
    const size_t kstep = (size_t)(BK * 2);
    const size_t hstepA = (size_t)HALF * g.lda * 2, hstepB = (size_t)HALF * g.ldb * 2;
    const unsigned ldsw = (unsigned)wid * 1024u;
    const int aoff = lds_byte(wr * 64 + fr, fq * 8), boff = lds_byte(wc * 32 + fr, fq * 8);
#define PG8_SA(b, h) (((b) * 2 + (h)) * HTB)
#define PG8_SB(b, h) ((4 + (b) * 2 + (h)) * HTB)
#define PG8_STAGE(bufoff, gbase, voff) do { _Pragma("unroll") for (int _i = 0; _i < 2; ++_i) \
        __builtin_amdgcn_global_load_lds((const unsigned*)((const char*)(gbase) + (voff)[_i]), (LAS unsigned*)(lds + (bufoff) + ldsw + _i * 8192), 16, 0, 0); } while (0)
#define PG8_LDA(dst, b, h) do { _Pragma("unroll") for (int m = 0; m < 4; ++m) _Pragma("unroll") for (int k = 0; k < 2; ++k) dst[m][k] = *(const LAS bf16x8*)(lds + PG8_SA(b, h) + aoff + m * 2048 + k * 1024); } while (0)
#define PG8_LDB(dst, b, h) do { _Pragma("unroll") for (int n = 0; n < 2; ++n) _Pragma("unroll") for (int k = 0; k < 2; ++k) dst[n][k] = *(const LAS bf16x8*)(lds + PG8_SB(b, h) + boff + n * 2048 + k * 1024); } while (0)
#define PG8_MMA(ai, bj, At, Bt) do { __builtin_amdgcn_s_setprio(1); _Pragma("unroll") for (int m = 0; m < 4; ++m) _Pragma("unroll") for (int n = 0; n < 2; ++n) _Pragma("unroll") for (int k = 0; k < 2; ++k) \
        acc[ai][bj][m][n] = __builtin_amdgcn_mfma_f32_16x16x32_bf16(Bt[n][k], At[m][k], acc[ai][bj][m][n], 0, 0, 0); __builtin_amdgcn_s_setprio(0); } while (0)
#define PG8_WAIT_V(n) asm volatile("s_waitcnt vmcnt(" #n ")" ::: "memory")
#define PG8_WAIT_L(n) asm volatile("s_waitcnt lgkmcnt(" #n ")" ::: "memory")
#define PG8_BAR __builtin_amdgcn_s_barrier()
#define PG8_SCHED __builtin_amdgcn_sched_barrier(0)
    Unit cur, nxt; int ui = 0;
    if (!S.next(0, cur)) return;
    f32x4 acc[2][2][4][2];
#pragma unroll
    for (int a = 0; a < 2; ++a)
#pragma unroll
        for (int b = 0; b < 2; ++b)
#pragma unroll
            for (int m = 0; m < 4; ++m)
#pragma unroll
                for (int n = 0; n < 2; ++n) acc[a][b][m][n] = (f32x4){0.f, 0.f, 0.f, 0.f};
    bf16x8 At[4][2], B0[2][2], B1[2][2];
    const char* cA = (const char*)g.A + (size_t)cur.pm * 2 * hstepA + (size_t)(cur.pn >> g.ashift) * g.astride * 2 + (size_t)cur.k0t * kstep;
    const char* cB = (const char*)g.Bt + (size_t)cur.pn * 2 * hstepB + (size_t)cur.k0t * kstep;
    PG8_STAGE(PG8_SB(0, 0), cB, voffB); PG8_STAGE(PG8_SB(0, 1), cB + hstepB, voffB); PG8_STAGE(PG8_SA(0, 0), cA, voffA); PG8_STAGE(PG8_SA(0, 1), cA + hstepA, voffA);
    if (wr == 1) PG8_BAR;
    PG8_WAIT_V(2); PG8_BAR;
    PG8_STAGE(PG8_SB(1, 0), cB + kstep, voffB); PG8_STAGE(PG8_SA(1, 0), cA + kstep, voffA); PG8_STAGE(PG8_SB(1, 1), cB + hstepB + kstep, voffB);
    PG8_WAIT_V(6); PG8_BAR;
    for (;;) {
        const bool has_next = S.next(ui + 1, nxt);
        const char* nA = has_next ? (const char*)g.A + (size_t)nxt.pm * 2 * hstepA + (size_t)(nxt.pn >> g.ashift) * g.astride * 2 + (size_t)nxt.k0t * kstep : cA;
        const char* nB = has_next ? (const char*)g.Bt + (size_t)nxt.pn * 2 * hstepB + (size_t)nxt.k0t * kstep : cB;
        const int unt = cur.split ? (nt >> 1) : nt;
        for (int t = 0; t < unt; t += 2) {
            const bool last = (t == unt - 2);
            const char* a1 = cA + (size_t)(t + 1) * kstep;
            const char* a2 = last ? nA : cA + (size_t)(t + 2) * kstep; const char* b2 = last ? nB : cB + (size_t)(t + 2) * kstep;
            const char* a3 = a2 + kstep; const char* b3 = b2 + kstep;
            PG8_LDB(B0, 0, 0); PG8_LDB(B1, 0, 1); PG8_SCHED; PG8_LDA(At, 0, 0); PG8_STAGE(PG8_SA(1, 1), a1 + hstepA, voffA);
            PG8_WAIT_V(8); PG8_WAIT_L(0); PG8_BAR; PG8_MMA(0, 0, At, B0); PG8_MMA(0, 1, At, B1); PG8_BAR; PG8_SCHED;
            PG8_LDA(At, 0, 1); PG8_STAGE(PG8_SB(0, 0), b2, voffB); PG8_STAGE(PG8_SB(0, 1), b2 + hstepB, voffB); PG8_STAGE(PG8_SA(0, 0), a2, voffA);
            PG8_WAIT_V(8); PG8_WAIT_L(0); PG8_BAR; PG8_MMA(1, 0, At, B0); PG8_MMA(1, 1, At, B1); PG8_BAR; PG8_SCHED;
            PG8_LDB(B0, 1, 0); PG8_LDB(B1, 1, 1); PG8_SCHED; PG8_LDA(At, 1, 0); PG8_STAGE(PG8_SA(0, 1), a2 + hstepA, voffA);
            PG8_WAIT_V(8); PG8_WAIT_L(0); PG8_BAR; PG8_MMA(0, 0, At, B0); PG8_MMA(0, 1, At, B1); PG8_BAR; PG8_SCHED;
            PG8_LDA(At, 1, 1); PG8_STAGE(PG8_SB(1, 0), b3, voffB); PG8_STAGE(PG8_SB(1, 1), b3 + hstepB, voffB); PG8_STAGE(PG8_SA(1, 0), a3, voffA);
            PG8_WAIT_V(8); PG8_WAIT_L(0); PG8_BAR; PG8_MMA(1, 0, At, B0); PG8_MMA(1, 1, At, B1); PG8_BAR; PG8_SCHED;
        }
        if (wr == 0) PG8_BAR;
        E(acc, cur, wr, wc, fr, fq);
        if (!has_next) break;
#pragma unroll
        for (int a = 0; a < 2; ++a)
#pragma unroll
            for (int b = 0; b < 2; ++b)
#pragma unroll
                for (int m = 0; m < 4; ++m)
#pragma unroll
                    for (int n = 0; n < 2; ++n) acc[a][b][m][n] = (f32x4){0.f, 0.f, 0.f, 0.f};
        cur = nxt; cA = nA; cB = nB; ++ui;
        if (wr == 1) PG8_BAR;
    }
    PG8_WAIT_V(0);
    PG8_BAR;
#undef PG8_SA
#undef PG8_SB
#undef PG8_STAGE
#undef PG8_LDA
#undef PG8_LDB
#undef PG8_MMA
#undef PG8_WAIT_V
#undef PG8_WAIT_L
#undef PG8_BAR
#undef PG8_SCHED
}

__device__ __forceinline__ f32x2 gelu_tanh_pk(f32x2 x) {
    const f32x2 x2 = x * x, p = x2 * 0.044715f + 1.0f, t = (x * p) * (-2.3022081986f);
    f32x2 e; e.x = __builtin_amdgcn_exp2f(t.x); e.y = __builtin_amdgcn_exp2f(t.y);
    const f32x2 d = e + 1.0f;
    f32x2 r; r.x = __builtin_amdgcn_rcpf(d.x); r.y = __builtin_amdgcn_rcpf(d.y);
    return x * r;
}
struct EpiBf16 {
    static constexpr bool PERM = true;
    bf16_t* O; int ldc; int act_from;
    __device__ __forceinline__ void operator()(const f32x4 (&acc)[2][2][4][2], const Unit& u, int wr, int wc, int fr, int fq) const {
        const int row0 = u.pm * BM + wr * 64 + fr, col0 = u.pn * BM + wc * 32 + 8 * fq; const bool act = u.pn >= act_from;
#pragma unroll
        for (int ai = 0; ai < 2; ++ai)
#pragma unroll
            for (int m = 0; m < 4; ++m) { bf16_t* rowp = O + (size_t)(row0 + ai * HALF + m * 16) * ldc + col0;
#pragma unroll
                for (int bj = 0; bj < 2; ++bj) { f32x4 v0 = acc[ai][bj][m][0], v1 = acc[ai][bj][m][1];
                    if (act) { const f32x2 a = gelu_tanh_pk((f32x2){v0[0], v0[1]}), b = gelu_tanh_pk((f32x2){v0[2], v0[3]}), c = gelu_tanh_pk((f32x2){v1[0], v1[1]}), d = gelu_tanh_pk((f32x2){v1[2], v1[3]});
                        v0 = (f32x4){a.x, a.y, b.x, b.y}; v1 = (f32x4){c.x, c.y, d.x, d.y}; }
                    u32x4 w; w.x = cvt_pk_bf16(v0[0], v0[1]); w.y = cvt_pk_bf16(v0[2], v0[3]); w.z = cvt_pk_bf16(v1[0], v1[1]); w.w = cvt_pk_bf16(v1[2], v1[3]);
                    *(u32x4*)(rowp + bj * HALF) = w; } }
    }
};
struct EpiPool {
    static constexpr bool PERM = true;
    bf16_t* O; int ldc; const float* scale;
    __device__ __forceinline__ void operator()(const f32x4 (&acc)[2][2][4][2], const Unit& u, int wr, int wc, int fr, int fq) const {
        const int row0 = u.pm * BM + wr * 64 + fr, col0 = u.pn * BM + wc * 32 + 8 * fq;
        f32x4 sv[2][2];
#pragma unroll
        for (int bj = 0; bj < 2; ++bj)
#pragma unroll
            for (int n = 0; n < 2; ++n) sv[bj][n] = *(const f32x4*)(scale + col0 + bj * HALF + 4 * n);
#pragma unroll
        for (int ai = 0; ai < 2; ++ai)
#pragma unroll
            for (int m = 0; m < 4; ++m) { bf16_t* rowp = O + (size_t)(row0 + ai * HALF + m * 16) * ldc + col0;
#pragma unroll
                for (int bj = 0; bj < 2; ++bj) { const f32x4 v0 = acc[ai][bj][m][0] * sv[bj][0], v1 = acc[ai][bj][m][1] * sv[bj][1];
                    u32x4 w; w.x = cvt_pk_bf16(v0[0], v0[1]); w.y = cvt_pk_bf16(v0[2], v0[3]); w.z = cvt_pk_bf16(v1[0], v1[1]); w.w = cvt_pk_bf16(v1[2], v1[3]);
                    *(u32x4*)(rowp + bj * HALF) = w; } }
    }
};
__device__ __forceinline__ f32x2 swiglu_pk(f32x2 g, f32x2 u) {
    const f32x2 t = g * (-1.4426950408889634f);
    f32x2 e; e.x = __builtin_amdgcn_exp2f(t.x); e.y = __builtin_amdgcn_exp2f(t.y);
    const f32x2 d = e + 1.0f;
    f32x2 r; r.x = __builtin_amdgcn_rcpf(d.x); r.y = __builtin_amdgcn_rcpf(d.y);
    return (g * u) * r;
}
struct EpiSwiGLU {
    static constexpr bool PERM = true;
    bf16_t* O; int ldc;
    __device__ __forceinline__ void operator()(const f32x4 (&acc)[2][2][4][2], const Unit& u, int wr, int wc, int fr, int fq) const {
        const int row0 = u.pm * BM + wr * 64 + fr, col0 = u.pn * HALF + wc * 32 + 8 * fq;
#pragma unroll
        for (int ai = 0; ai < 2; ++ai)
#pragma unroll
            for (int m = 0; m < 4; ++m) { bf16_t* rowp = O + (size_t)(row0 + ai * HALF + m * 16) * ldc + col0;
                const f32x4 g0 = acc[ai][0][m][0], g1 = acc[ai][0][m][1], u0 = acc[ai][1][m][0], u1 = acc[ai][1][m][1];
                const f32x2 h0 = swiglu_pk((f32x2){g0[0], g0[1]}, (f32x2){u0[0], u0[1]}), h1 = swiglu_pk((f32x2){g0[2], g0[3]}, (f32x2){u0[2], u0[3]});
                const f32x2 h2 = swiglu_pk((f32x2){g1[0], g1[1]}, (f32x2){u1[0], u1[1]}), h3 = swiglu_pk((f32x2){g1[2], g1[3]}, (f32x2){u1[2], u1[3]});
                u32x4 w; w.x = cvt_pk_bf16(h0.x, h0.y); w.y = cvt_pk_bf16(h1.x, h1.y); w.z = cvt_pk_bf16(h2.x, h2.y); w.w = cvt_pk_bf16(h3.x, h3.y);
                *(u32x4*)rowp = w; }
    }
};
struct EpiResGate {
    static constexpr bool PERM = true;
    float* X; const float* xin; const float* ctxin; const float* gate; bool from_input; bf16_t* XB; float* PART;
    __device__ __forceinline__ void operator()(const f32x4 (&acc)[2][2][4][2], const Unit& u, int wr, int wc, int fr, int fq) const {
        const int lrow0 = wr * 64 + fr, col0 = u.pn * BM + wc * 32 + 8 * fq;
        const int b = u.pm / 9, p = u.pm % 9;
        if (u.split) {
            float* po = PART + ((size_t)(u.split - 1) * NB * CTXL + (size_t)b * CTXL) * D + col0;
#pragma unroll
            for (int ai = 0; ai < 2; ++ai)
#pragma unroll
                for (int m = 0; m < 4; ++m) { const size_t ro = (size_t)(lrow0 + ai * HALF + m * 16) * D;
#pragma unroll
                    for (int bj = 0; bj < 2; ++bj) { *(f32x4*)(po + ro + bj * HALF) = acc[ai][bj][m][0]; *(f32x4*)(po + ro + bj * HALF + 4) = acc[ai][bj][m][1]; } }
            return;
        }
        const float* gp = gate + (size_t)(p == 0 ? 8 : b) * MODW + col0;
        const float* bs = from_input ? (p == 0 ? ctxin + (size_t)b * CTXL * D : xin + ((size_t)b * SEQ + (size_t)(p - 1) * 256) * D) + col0 : nullptr;
        bf16_t* xb = XB + (size_t)u.pm * BM * D + col0;
        f32x4 gv[2][2];
#pragma unroll
        for (int bj = 0; bj < 2; ++bj)
#pragma unroll
            for (int n = 0; n < 2; ++n) gv[bj][n] = *(const f32x4*)(gp + bj * HALF + n * 4);
#pragma unroll
        for (int q = 0; q < 4; ++q) {
            const int ai = q >> 1, m0 = (q & 1) * 2;
            f32x4 bv[2][2][2];
            if (from_input) {
#pragma unroll
                for (int mm = 0; mm < 2; ++mm) { const size_t ro = (size_t)(lrow0 + ai * HALF + (m0 + mm) * 16) * D;
#pragma unroll
                    for (int bj = 0; bj < 2; ++bj) { bv[mm][bj][0] = *(const f32x4*)(bs + ro + bj * HALF); bv[mm][bj][1] = *(const f32x4*)(bs + ro + bj * HALF + 4); } }
            } else {
                u32x4 bw[2][2];
#pragma unroll
                for (int mm = 0; mm < 2; ++mm) { const size_t ro = (size_t)(lrow0 + ai * HALF + (m0 + mm) * 16) * D;
#pragma unroll
                    for (int bj = 0; bj < 2; ++bj) bw[mm][bj] = *(const u32x4*)(xb + ro + bj * HALF); }
#pragma unroll
                for (int mm = 0; mm < 2; ++mm)
#pragma unroll
                    for (int bj = 0; bj < 2; ++bj) { const u32x4 w = bw[mm][bj];
                        bv[mm][bj][0] = (f32x4){bf_lo(w.x), bf_hi(w.x), bf_lo(w.y), bf_hi(w.y)}; bv[mm][bj][1] = (f32x4){bf_lo(w.z), bf_hi(w.z), bf_lo(w.w), bf_hi(w.w)}; }
            }
            asm volatile("" ::: "memory");
#pragma unroll
            for (int mm = 0; mm < 2; ++mm) { const int m = m0 + mm; const size_t ro = (size_t)(lrow0 + ai * HALF + m * 16) * D;
#pragma unroll
                for (int bj = 0; bj < 2; ++bj) {
                    const f32x4 o0 = bv[mm][bj][0] + gv[bj][0] * acc[ai][bj][m][0], o1 = bv[mm][bj][1] + gv[bj][1] * acc[ai][bj][m][1];
                    u32x4 w; w.x = cvt_pk_bf16(o0[0], o0[1]); w.y = cvt_pk_bf16(o0[2], o0[3]); w.z = cvt_pk_bf16(o1[0], o1[1]); w.w = cvt_pk_bf16(o1[2], o1[3]); *(u32x4*)(xb + ro + bj * HALF) = w; } }
            asm volatile("" ::: "memory");
        }
    }
};
}

namespace att {
constexpr int NW = 8, QBLK = 32, KVBLK = 64;
constexpr int SHM_V = KVBLK * 128 * 2, SHM_K = KVBLK * 128 * 2, SHM_K2 = KVBLK * 64 * 2;
constexpr int OFF_V = 0, OFF_K = 2 * SHM_V, OFF_K2 = OFF_K + 2 * SHM_K, OFF_WS = OFF_K2 + 2 * SHM_K2, OFF_QR = OFF_WS + NW * 64 * 4, ATT_LDS = OFF_QR + NW * 4096;
#define KSWZ(row, colB) ((row) * 256 + ((colB) ^ (((row) & 7) << 4)))
#define KSWZ2(row, colB) ((row) * 128 + ((colB) ^ ((((row) >> 1) & 7) << 4)))
#define SBAR() __builtin_amdgcn_sched_barrier(0)
__device__ __forceinline__ int crow(int r, int hi) { return (r & 3) + 8 * (r >> 2) + 4 * hi; }
__device__ __forceinline__ void partialSM(f32x16& p0, f32x16& p1, float& m_reg, float& mn, float& alpha, const float C, const float thr_s) {
  float pmax = p0[0];
#pragma unroll
  for (int r = 1; r < 16; ++r) pmax = fmaxf(pmax, p0[r]);
#pragma unroll
  for (int r = 0; r < 16; ++r) pmax = fmaxf(pmax, p1[r]);
  { auto rr = __builtin_amdgcn_permlane32_swap(__float_as_uint(pmax), __float_as_uint(pmax), false, false);
    pmax = fmaxf(__uint_as_float(rr[0]), __uint_as_float(rr[1])); }
  if (__builtin_expect(__all(pmax - m_reg <= thr_s), 1)) { mn = m_reg; alpha = 1.f; }
  else { mn = fmaxf(m_reg, pmax); alpha = __builtin_amdgcn_exp2f((m_reg - mn) * C); m_reg = mn; }
  const float mnC = -mn * C;
#pragma unroll
  for (int r = 0; r < 16; ++r) p0[r] = fmaf(p0[r], C, mnC);
#pragma unroll
  for (int r = 0; r < 16; ++r) p1[r] = fmaf(p1[r], C, mnC);
#pragma unroll
  for (int r = 0; r < 16; ++r) p0[r] = __builtin_amdgcn_exp2f(p0[r]);
}
__device__ __forceinline__ void finishSM(f32x16& p0, f32x16& p1, float alpha, float& l_reg, bf16x8& pa0, bf16x8& pa1, bf16x8& pa2, bf16x8& pa3) {
#pragma unroll
  for (int r = 0; r < 16; ++r) p1[r] = __builtin_amdgcn_exp2f(p1[r]);
  float ps = 0;
#pragma unroll
  for (int r = 0; r < 16; ++r) ps += p0[r];
#pragma unroll
  for (int r = 0; r < 16; ++r) ps += p1[r];
  { auto rr = __builtin_amdgcn_permlane32_swap(__float_as_uint(ps), __float_as_uint(ps), false, false);
    ps = __uint_as_float(rr[0]) + __uint_as_float(rr[1]); }
  l_reg = l_reg * alpha + ps;
#define PK4(P, BASE, OUT) do { unsigned a0 = cvt_pk_bf16(P[BASE + 0], P[BASE + 1]), a1 = cvt_pk_bf16(P[BASE + 2], P[BASE + 3]);   \
    unsigned b0 = cvt_pk_bf16(P[BASE + 4], P[BASE + 5]), b1 = cvt_pk_bf16(P[BASE + 6], P[BASE + 7]);                              \
    auto r0 = __builtin_amdgcn_permlane32_swap(a0, b0, false, false); auto r1 = __builtin_amdgcn_permlane32_swap(a1, b1, false, false); \
    u32x4 w = {r0[0], r1[0], r0[1], r1[1]}; OUT = *reinterpret_cast<bf16x8*>(&w); } while (0)
  PK4(p0, 0, pa0); PK4(p0, 8, pa1); PK4(p1, 0, pa2); PK4(p1, 8, pa3);
#undef PK4
}
template <int DQK, bool QRL = false>
__device__ __forceinline__ void qkt(f32x16& p0, f32x16& p1, const char* Ks, const char* K2s, const bf16x8* qr, int r32, int hi, const char* qrl = nullptr) {
  p0 = f32x16{}; p1 = f32x16{};
#pragma unroll
  for (int d0 = 0; d0 < 8; ++d0) { const int cb = (d0 * 16 + hi * 8) * 2;
    const bf16x8 b0 = *reinterpret_cast<const bf16x8*>(Ks + KSWZ(r32, cb));
    const bf16x8 b1 = *reinterpret_cast<const bf16x8*>(Ks + KSWZ(32 + r32, cb));
    p0 = __builtin_amdgcn_mfma_f32_32x32x16_bf16(b0, qr[d0], p0, 0, 0, 0);
    p1 = __builtin_amdgcn_mfma_f32_32x32x16_bf16(b1, qr[d0], p1, 0, 0, 0); }
  if constexpr (DQK == 192) {
#pragma unroll
    for (int d0 = 0; d0 < 4; ++d0) { const int cb = (d0 * 16 + hi * 8) * 2;
      const bf16x8 b0 = *reinterpret_cast<const bf16x8*>(K2s + KSWZ2(r32, cb));
      const bf16x8 b1 = *reinterpret_cast<const bf16x8*>(K2s + KSWZ2(32 + r32, cb));
      bf16x8 q; if constexpr (QRL) q = *reinterpret_cast<const bf16x8*>(qrl + d0 * 1024); else q = qr[8 + d0];
      p0 = __builtin_amdgcn_mfma_f32_32x32x16_bf16(b0, q, p0, 0, 0, 0);
      p1 = __builtin_amdgcn_mfma_f32_32x32x16_bf16(b1, q, p1, 0, 0, 0); }
  }
}
__device__ __forceinline__ int v_st(int k, int c) { const int kk = (k & ~0xC) | ((k & 4) << 1) | ((k & 8) >> 1); return ((kk >> 3) * 4 + (c >> 5)) * 512 + ((kk & 7) * 32 + (c & 31)) * 2; }
__device__ __forceinline__ int v_rd_base(int lane) { return ((lane & 3) << 3) | (((lane >> 2) & 3) << 6) | (((lane >> 4) & 1) << 5) | (((lane >> 5) & 1) << 8); }
constexpr int v_rd_off(int d0, int ks, int half) { return d0 * 512 + ks * 4096 + half * 2048; }
template <int OFF> __device__ __forceinline__ s16x4 tr_read(int vb) {
  s16x4 r; asm volatile("ds_read_b64_tr_b16 %0, %1 offset:%2" : "=&v"(r) : "v"(vb), "i"(OFF) : "memory"); return r;
}
template <int D0> __device__ __forceinline__ void pv_one(f32x16& od, int vb, bf16x8 pa0, bf16x8 pa1, bf16x8 pa2, bf16x8 pa3) {
  const s16x4 l0 = tr_read<v_rd_off(D0, 0, 0)>(vb), h0 = tr_read<v_rd_off(D0, 0, 1)>(vb), l1 = tr_read<v_rd_off(D0, 1, 0)>(vb), h1 = tr_read<v_rd_off(D0, 1, 1)>(vb);
  const s16x4 l2 = tr_read<v_rd_off(D0, 2, 0)>(vb), h2 = tr_read<v_rd_off(D0, 2, 1)>(vb), l3 = tr_read<v_rd_off(D0, 3, 0)>(vb), h3 = tr_read<v_rd_off(D0, 3, 1)>(vb);
  asm volatile("s_waitcnt lgkmcnt(0)" ::: "memory"); SBAR();
#define PK(L, H) (bf16x8){L[0], L[1], L[2], L[3], H[0], H[1], H[2], H[3]}
  od = __builtin_amdgcn_mfma_f32_32x32x16_bf16(pa0, PK(l0, h0), od, 0, 0, 0);
  od = __builtin_amdgcn_mfma_f32_32x32x16_bf16(pa1, PK(l1, h1), od, 0, 0, 0);
  od = __builtin_amdgcn_mfma_f32_32x32x16_bf16(pa2, PK(l2, h2), od, 0, 0, 0);
  od = __builtin_amdgcn_mfma_f32_32x32x16_bf16(pa3, PK(l3, h3), od, 0, 0, 0);
#undef PK
}
__device__ __forceinline__ void pv_d0(f32x16* o, int vb, bf16x8 pa0, bf16x8 pa1, bf16x8 pa2, bf16x8 pa3) {
  pv_one<0>(o[0], vb, pa0, pa1, pa2, pa3); pv_one<1>(o[1], vb, pa0, pa1, pa2, pa3); pv_one<2>(o[2], vb, pa0, pa1, pa2, pa3); pv_one<3>(o[3], vb, pa0, pa1, pa2, pa3);
}
template <int D0> __device__ __forceinline__ void pvT_one(f32x16& od, int vb, bf16x8 pa0, bf16x8 pa1, bf16x8 pa2, bf16x8 pa3) {
  const s16x4 l0 = tr_read<v_rd_off(D0, 0, 0)>(vb), h0 = tr_read<v_rd_off(D0, 0, 1)>(vb), l1 = tr_read<v_rd_off(D0, 1, 0)>(vb), h1 = tr_read<v_rd_off(D0, 1, 1)>(vb);
  const s16x4 l2 = tr_read<v_rd_off(D0, 2, 0)>(vb), h2 = tr_read<v_rd_off(D0, 2, 1)>(vb), l3 = tr_read<v_rd_off(D0, 3, 0)>(vb), h3 = tr_read<v_rd_off(D0, 3, 1)>(vb);
  asm volatile("s_waitcnt lgkmcnt(0)" ::: "memory"); SBAR();
#define PK(L, H) (bf16x8){L[0], L[1], L[2], L[3], H[0], H[1], H[2], H[3]}
  od = __builtin_amdgcn_mfma_f32_32x32x16_bf16(PK(l0, h0), pa0, od, 0, 0, 0);
  od = __builtin_amdgcn_mfma_f32_32x32x16_bf16(PK(l1, h1), pa1, od, 0, 0, 0);
  od = __builtin_amdgcn_mfma_f32_32x32x16_bf16(PK(l2, h2), pa2, od, 0, 0, 0);
  od = __builtin_amdgcn_mfma_f32_32x32x16_bf16(PK(l3, h3), pa3, od, 0, 0, 0);
#undef PK
}
__device__ __forceinline__ void pvT_d0(f32x16* o, int vb, bf16x8 pa0, bf16x8 pa1, bf16x8 pa2, bf16x8 pa3) {
  pvT_one<0>(o[0], vb, pa0, pa1, pa2, pa3); pvT_one<1>(o[1], vb, pa0, pa1, pa2, pa3); pvT_one<2>(o[2], vb, pa0, pa1, pa2, pa3); pvT_one<3>(o[3], vb, pa0, pa1, pa2, pa3);
}
template <int DQK, int SDEPTH, int LDQ, int LDK, int LDK2, int LDV, int LDO>
__device__ __forceinline__ void attn_body(const bf16_t* __restrict__ Qb, const bf16_t* __restrict__ Kh, const bf16_t* __restrict__ K2h, const bf16_t* __restrict__ Vh,
                                          bf16_t* __restrict__ Ob, int seq, const float scale, char* lds, const int wave, const float* __restrict__ ropec = nullptr, const float* __restrict__ ropes = nullptr) {
  const float C = scale * 1.4426950408889634f, thr_s = 8.f / scale;
  const int tid = launder_tid(wave), wid = wave, lane = tid & 63, r32 = lane & 31, hi = lane >> 5;
  char* V_lds = lds + OFF_V; char* K_lds = lds + OFF_K; char* K2_lds = lds + OFF_K2;
  const char* qrl = lds + OFF_QR + wid * 4096 + lane * 16;
  float m_reg = -1e30f, l_reg = 0; f32x16 o[4] = {}; bf16x8 qr[8];
  const bf16_t* Qw = Qb + (long)(wid * QBLK + r32) * LDQ + hi * 8;
#pragma unroll
  for (int d0 = 0; d0 < 8; ++d0) qr[d0] = *reinterpret_cast<const bf16x8*>(Qw + d0 * 16);
  if constexpr (DQK == 192) {
    const float* cp = ropec + (wid * QBLK + r32) * 32 + 8 * hi; const float* sp = ropes + (wid * QBLK + r32) * 32 + 8 * hi;
#pragma unroll
    for (int e = 0; e < 2; ++e) {
      const f32x4 c0 = *(const f32x4*)(cp + 16 * e), c1 = *(const f32x4*)(cp + 16 * e + 4), s0 = *(const f32x4*)(sp + 16 * e), s1 = *(const f32x4*)(sp + 16 * e + 4);
      const u32x4 a = *reinterpret_cast<const u32x4*>(Qw + (8 + e) * 16), b = *reinterpret_cast<const u32x4*>(Qw + (10 + e) * 16);
      const float x1[8] = {bf_lo(a.x), bf_hi(a.x), bf_lo(a.y), bf_hi(a.y), bf_lo(a.z), bf_hi(a.z), bf_lo(a.w), bf_hi(a.w)};
      const float x2[8] = {bf_lo(b.x), bf_hi(b.x), bf_lo(b.y), bf_hi(b.y), bf_lo(b.z), bf_hi(b.z), bf_lo(b.w), bf_hi(b.w)};
      const float cc[8] = {c0.x, c0.y, c0.z, c0.w, c1.x, c1.y, c1.z, c1.w}, sn[8] = {s0.x, s0.y, s0.z, s0.w, s1.x, s1.y, s1.z, s1.w};
      float y1[8], y2[8];
#pragma unroll
      for (int j = 0; j < 8; ++j) { y1[j] = x1[j] * cc[j] - x2[j] * sn[j]; y2[j] = x1[j] * sn[j] + x2[j] * cc[j]; }
      u32x4 oa, ob; oa.x = cvt_pk_bf16(y1[0], y1[1]); oa.y = cvt_pk_bf16(y1[2], y1[3]); oa.z = cvt_pk_bf16(y1[4], y1[5]); oa.w = cvt_pk_bf16(y1[6], y1[7]);
      ob.x = cvt_pk_bf16(y2[0], y2[1]); ob.y = cvt_pk_bf16(y2[2], y2[3]); ob.z = cvt_pk_bf16(y2[4], y2[5]); ob.w = cvt_pk_bf16(y2[6], y2[7]);
      *(u32x4*)(const_cast<char*>(qrl) + e * 1024) = oa; *(u32x4*)(const_cast<char*>(qrl) + (2 + e) * 1024) = ob;
    }
    asm volatile("s_waitcnt lgkmcnt(0)" ::: "memory");
  }
  const int sr = tid >> 4, sc = (tid & 15) * 8, vst0 = v_st(sr, sc), vst1 = v_st(32 + sr, sc);
  const int s2r = tid >> 3, s2c = (tid & 7) * 8;
  const int vb0 = (int)(uintptr_t)V_lds + v_rd_base(lane);
  struct { bf16x8 vs0, vs1, ks0, ks1, k2; } sr_[SDEPTH];
#define SLOAD(i, k0) do { sr_[i].vs0 = *reinterpret_cast<const bf16x8*>(&Vh[(long)((k0) + sr) * LDV + sc]); sr_[i].vs1 = *reinterpret_cast<const bf16x8*>(&Vh[(long)((k0) + 32 + sr) * LDV + sc]); \
    sr_[i].ks0 = *reinterpret_cast<const bf16x8*>(&Kh[(long)((k0) + sr) * LDK + sc]); sr_[i].ks1 = *reinterpret_cast<const bf16x8*>(&Kh[(long)((k0) + 32 + sr) * LDK + sc]); \
    if constexpr (DQK == 192) sr_[i].k2 = *reinterpret_cast<const bf16x8*>(&K2h[(long)((k0) + s2r) * LDK2 + s2c]); } while (0)
#define SWRITE(b, i) do { *(bf16x8*)(V_lds + (b) * SHM_V + vst0) = sr_[i].vs0; *(bf16x8*)(V_lds + (b) * SHM_V + vst1) = sr_[i].vs1; const int kc = sc * 2; \
    *(bf16x8*)(K_lds + (b) * SHM_K + KSWZ(sr, kc)) = sr_[i].ks0; *(bf16x8*)(K_lds + (b) * SHM_K + KSWZ(32 + sr, kc)) = sr_[i].ks1; \
    if constexpr (DQK == 192) *(bf16x8*)(K2_lds + (b) * SHM_K2 + KSWZ2(s2r, s2c * 2)) = sr_[i].k2; } while (0)
#define SWAIT() do { if constexpr (SDEPTH == 1) asm volatile("s_waitcnt vmcnt(0)" ::: "memory"); else if constexpr (DQK == 192) asm volatile("s_waitcnt vmcnt(5)" ::: "memory"); else asm volatile("s_waitcnt vmcnt(4)" ::: "memory"); } while (0)
#define RESC(a) do { if (__any((a) < 1.f)) { _Pragma("unroll") for (int d = 0; d < 4; ++d) _Pragma("unroll") for (int r = 0; r < 16; ++r) o[d][r] *= (a); } } while (0)
  f32x16 pA0, pA1, pB0, pB1; float mnA, mnB, alA, alB; bf16x8 pa0, pa1, pa2, pa3; const int NT = seq / KVBLK;
  constexpr int SE = 0, SO = SDEPTH - 1;
  SLOAD(SE, 0); asm volatile("s_waitcnt vmcnt(0)" ::: "memory"); SWRITE(0, SE); __syncthreads();
  qkt<DQK, true>(pA0, pA1, K_lds, K2_lds, qr, r32, hi, qrl); partialSM(pA0, pA1, m_reg, mnA, alA, C, thr_s);
  SLOAD(SO, KVBLK); if constexpr (SDEPTH == 2) { if (2 < NT) SLOAD(SE, 2 * KVBLK); }
  SWAIT(); SWRITE(1, SO); __syncthreads();
  for (int j = 1; j + 1 < NT; j += 2) {
    SBAR(); qkt<DQK, true>(pB0, pB1, K_lds + SHM_K, K2_lds + SHM_K2, qr, r32, hi, qrl);
    finishSM(pA0, pA1, alA, l_reg, pa0, pa1, pa2, pa3); SBAR();
    SLOAD(SO, (j + SDEPTH) * KVBLK); SBAR();
    pvT_d0(o, vb0, pa0, pa1, pa2, pa3); partialSM(pB0, pB1, m_reg, mnB, alB, C, thr_s);
    __syncthreads(); SWAIT(); SWRITE(0, SE);
    RESC(alB); __syncthreads();
    SBAR(); qkt<DQK, true>(pA0, pA1, K_lds, K2_lds, qr, r32, hi, qrl);
    finishSM(pB0, pB1, alB, l_reg, pa0, pa1, pa2, pa3); SBAR();
    if (SDEPTH == 1 || j + 3 < NT) SLOAD(SE, (j + 1 + SDEPTH) * KVBLK); SBAR();
    pvT_d0(o, vb0 + SHM_V, pa0, pa1, pa2, pa3); partialSM(pA0, pA1, m_reg, mnA, alA, C, thr_s);
    __syncthreads(); SWAIT(); SWRITE(1, SO);
    RESC(alA); __syncthreads();
  }
  SBAR(); qkt<DQK, true>(pB0, pB1, K_lds + SHM_K, K2_lds + SHM_K2, qr, r32, hi, qrl);
  finishSM(pA0, pA1, alA, l_reg, pa0, pa1, pa2, pa3); SBAR();
  pvT_d0(o, vb0, pa0, pa1, pa2, pa3); partialSM(pB0, pB1, m_reg, mnB, alB, C, thr_s);
  __syncthreads(); RESC(alB);
  finishSM(pB0, pB1, alB, l_reg, pa0, pa1, pa2, pa3); SBAR();
  pvT_d0(o, vb0 + SHM_V, pa0, pa1, pa2, pa3);
  { const float rl = __builtin_amdgcn_rcpf(l_reg);
    bf16_t* Ow = Ob + (long)(wid * QBLK + r32) * LDO + 4 * hi;
#pragma unroll
    for (int d0 = 0; d0 < 4; ++d0)
#pragma unroll
      for (int g = 0; g < 4; ++g) { u32x2 w; w.x = cvt_pk_bf16(o[d0][4 * g + 0] * rl, o[d0][4 * g + 1] * rl); w.y = cvt_pk_bf16(o[d0][4 * g + 2] * rl, o[d0][4 * g + 3] * rl);
        *(u32x2*)(Ow + d0 * 32 + 8 * g) = w; } }
  __syncthreads();
#undef SLOAD
#undef SWRITE
#undef SWAIT
#undef RESC
}

}

#define XB_TMO      128
#define XB_XCNT(j)  (256  + 64 * (j))
#define XB_XSUB(j)  (1280 + 64 * (j))
#define XB_XGEN(j)  (2304 + 64 * (j))
#define XB_TOP      3328
#define XB_TOPGEN   3392
#define XCD_BAR_WORDS 3456
#define XB_SPIN_CAP (1u << 18)
__device__ __forceinline__ unsigned xb_ld(unsigned* p)              { return __hip_atomic_load(p, __ATOMIC_RELAXED, __HIP_MEMORY_SCOPE_AGENT); }
__device__ __forceinline__ unsigned xb_add(unsigned* p, unsigned v) { return __hip_atomic_fetch_add(p, v, __ATOMIC_RELAXED, __HIP_MEMORY_SCOPE_AGENT); }
__device__ __forceinline__ unsigned xb_xcc_id() { return (unsigned)__builtin_amdgcn_s_getreg((3 << 11) | 20) & 0xFu; }
#define XB_SPIN(cond, bar) do { unsigned _sp = 0; while (cond) { __builtin_amdgcn_s_sleep(1); \
    if ((++_sp & 255u) == 0u) { if (xb_ld(&(bar)[XB_TMO])) break; if (_sp > XB_SPIN_CAP) { atomicAdd(&(bar)[XB_TMO], 1u); break; } } } } while (0)
struct XcdBarrier { unsigned* bar; unsigned x; volatile LAS unsigned* st; };
__device__ __forceinline__ XcdBarrier xcd_barrier_post(unsigned* bar, volatile LAS unsigned* st) {
    XcdBarrier b; b.bar = bar; b.x = xb_xcc_id(); b.st = st;
    if (threadIdx.x == 0) (void)xb_add(&bar[XB_XCNT(b.x)], 1u);
    return b;
}
__device__ __forceinline__ void xcd_barrier_complete(unsigned* bar, unsigned x, unsigned& nloc, unsigned& nx) {
    const unsigned G = gridDim.x * gridDim.y * gridDim.z;
    unsigned sum, cnt, mine, sp = 0u;
    for (;;) {
        sum = 0u; cnt = 0u; mine = 0u;
#pragma unroll
        for (unsigned j = 0; j < 16; ++j) { const unsigned c = xb_ld(&bar[XB_XCNT(j)]); sum += c; cnt += (c > 0u) ? 1u : 0u; mine = (j == x) ? c : mine; }
        if (sum == G) break;
        __builtin_amdgcn_s_sleep(1);
        if ((++sp & 255u) == 0u) { if (xb_ld(&bar[XB_TMO])) break; if (sp > XB_SPIN_CAP) { atomicAdd(&bar[XB_TMO], 1u); break; } }
    }
    nloc = mine > 0u ? mine : 1u; nx = cnt > 0u ? cnt : 1u;
}
__device__ __forceinline__ void xcd_barrier(const XcdBarrier& b) {
    asm volatile("s_waitcnt vmcnt(0)" ::: "memory");
    __syncthreads();
    if (threadIdx.x == 0) {
        unsigned* bar = b.bar;
        __builtin_amdgcn_s_waitcnt(0);
        unsigned nloc = b.st[0], nx = b.st[1];
        if (nloc == 0u) { xcd_barrier_complete(bar, b.x, nloc, nx); b.st[0] = nloc; b.st[1] = nx; }
        const unsigned old = xb_add(&bar[XB_XSUB(b.x)], 1u);
        const unsigned gen = old / nloc;
        if (old + 1u == (gen + 1u) * nloc) {
            __builtin_amdgcn_fence(__ATOMIC_RELEASE, "agent");
            asm volatile("s_waitcnt vmcnt(0)" ::: "memory");
            const unsigned og = xb_add(&bar[XB_TOP], 1u);
            const unsigned tg = og / nx;
            if (og + 1u == (tg + 1u) * nx) xb_add(&bar[XB_TOPGEN], 1u);
            else XB_SPIN(xb_ld(&bar[XB_TOPGEN]) == tg, bar);
            __builtin_amdgcn_fence(__ATOMIC_ACQUIRE, "agent");
            xb_add(&bar[XB_XGEN(b.x)], 1u);
            asm volatile("s_waitcnt vmcnt(0)" ::: "memory");
        } else {
            XB_SPIN(xb_ld(&bar[XB_XGEN(b.x)]) == gen, bar);
            __builtin_amdgcn_fence(__ATOMIC_ACQUIRE, "agent");
            asm volatile("s_waitcnt vmcnt(0)" ::: "memory");
        }
    }
    __syncthreads();
}

struct Args { const float* in[26]; float* out; unsigned char* ws; int ph_lo, ph_hi; };
enum { I_X = 0, I_C, I_CTX, I_CCTX, I_MODW, I_MODB, I_N1G, I_N2G, I_FING, I_WGU, I_WDOWN, I_EVIN, I_POOLW, I_POOLS, I_SGUNG, I_SGUWS, I_SGUB, I_EVOUT,
       I_ODIN, I_QAG, I_WQB, I_KVAG, I_WKVB, I_QNG, I_KNG, I_ODOUT };
constexpr int N_PHASES = 20;
constexpr int GQA_SDEPTH = 1, MLA_SDEPTH = 1;
constexpr int NH_P2 = 8, NH_P7 = 8, NH_P17 = 0;

__device__ __forceinline__ void conv_item(const float* __restrict__ W, int K, int N, bf16_t* __restrict__ WT, int map, int it, LAS unsigned char* tile, int lane) {
    const int nnb = N / 64;
    const int kq = lane >> 4, nq = lane & 15, rn = lane >> 3, ch = lane & 7;
    const int kc = it / nnb, nb = it - kc * nnb, n0 = nb * 64;
    int dr = n0;
    if (map == 1) { const int isu = n0 >= FFH, j = isu ? n0 - FFH : n0; dr = 256 * (j >> 7) + (isu ? 128 : 0) + (j & 127); }
    else if (map == 2) { dr = n0 < 3584 ? n0 : (n0 < 3648 ? OC_KR + (n0 - 3584) : n0 - 64); }
    const float* src = W + (size_t)(kc * 64 + 16 * kq) * N + n0 + 4 * nq;
    f32x4 v[16];
#pragma unroll
    for (int i = 0; i < 16; ++i) v[i] = __builtin_nontemporal_load((const f32x4*)(src + (size_t)i * N));
#pragma unroll
    for (int j = 0; j < 4; ++j) {
        u32x4 c0, c1;
        c0.x = cvt_pk_bf16(v[0][j], v[1][j]); c0.y = cvt_pk_bf16(v[2][j], v[3][j]); c0.z = cvt_pk_bf16(v[4][j], v[5][j]); c0.w = cvt_pk_bf16(v[6][j], v[7][j]);
        c1.x = cvt_pk_bf16(v[8][j], v[9][j]); c1.y = cvt_pk_bf16(v[10][j], v[11][j]); c1.z = cvt_pk_bf16(v[12][j], v[13][j]); c1.w = cvt_pk_bf16(v[14][j], v[15][j]);
        const int n = 4 * nq + j, sw = nq & 7;
        *(LAS u32x4*)(tile + n * 128 + (((2 * kq) ^ sw) << 4)) = c0; *(LAS u32x4*)(tile + n * 128 + (((2 * kq + 1) ^ sw) << 4)) = c1;
    }
    LDS_WAIT(); asm volatile("" ::: "memory");
    bf16_t* dst = WT + (size_t)dr * K + kc * 64 + 8 * ch;
#pragma unroll
    for (int t = 0; t < 8; ++t) { const int n = rn + 8 * t; const u32x4 o = *(const LAS u32x4*)(tile + n * 128 + ((ch ^ ((n >> 2) & 7)) << 4)); *(u32x4*)(dst + (size_t)n * K) = o; }
    LDS_WAIT(); asm volatile("" ::: "memory");
}
constexpr int CI_POOL = 0, CI_EVOUT = CI_POOL + 4 * 64, CI_GU0 = CI_EVOUT + 4096, CI_DOWN0 = CI_GU0 + 22016, CI_ODIN = CI_DOWN0 + 11008, CI_QB = CI_ODIN + 4672, CI_KVB = CI_QB + 768,
              CI_ODOUT = CI_KVB + 512, CI_GU1 = CI_ODOUT + 4096, CI_DOWN1 = CI_GU1 + 22016, CI_END = CI_DOWN1 + 11008;
constexpr int CV_P0A_LO = 0,        CV_P0A_HI = CI_DOWN0;
constexpr int CV_P2_LO = CI_DOWN0,  CV_P2_HI = CI_DOWN0 + 5500;
constexpr int CV_P7_LO = CV_P2_HI,  CV_P7_HI = CI_DOWN0 + 26500;
constexpr int CV_P0B_LO = CI_END,  CV_P0B_HI = CI_END;
constexpr int CV_OPT_LO = CV_P7_HI, CV_OPT_HI = CI_END;
constexpr int CV_P17_LO = CI_END, CV_P17_HI = CI_END;
struct ConvCtx { const float* pool; const float* evout; const float* gu; const float* down; const float* odin; const float* qb; const float* kvb; const float* odout; unsigned char* ws; };
__device__ __forceinline__ void conv_list_item(const ConvCtx& c, int it, LAS unsigned char* tile, int lane) {
    if (it < CI_EVOUT) { const int g = it >> 6; conv_item(c.pool + (size_t)g * 512 * 512, 512, 512, (bf16_t*)(c.ws + WS_WPOOL) + (size_t)g * 512 * 512, 0, it & 63, tile, lane); }
    else if (it < CI_GU0) conv_item(c.evout, D, D, (bf16_t*)(c.ws + WS_WEVOUT), 0, it - CI_EVOUT, tile, lane);
    else if (it < CI_DOWN0) conv_item(c.gu, D, FFN2, (bf16_t*)(c.ws + WS_WGU), 1, it - CI_GU0, tile, lane);
    else if (it < CI_ODIN) conv_item(c.down, FFH, D, (bf16_t*)(c.ws + WS_WDOWN), 0, it - CI_DOWN0, tile, lane);
    else if (it < CI_QB) conv_item(c.odin, D, ODIN, (bf16_t*)(c.ws + WS_WODIN), 2, it - CI_ODIN, tile, lane);
    else if (it < CI_KVB) conv_item(c.qb, 1024, QMW, (bf16_t*)(c.ws + WS_WQB), 0, it - CI_QB, tile, lane);
    else if (it < CI_ODOUT) conv_item(c.kvb, 512, KVW, (bf16_t*)(c.ws + WS_WKVB), 0, it - CI_KVB, tile, lane);
    else if (it < CI_GU1) conv_item(c.odout, D, D, (bf16_t*)(c.ws + WS_WODOUT), 0, it - CI_ODOUT, tile, lane);
    else if (it < CI_DOWN1) conv_item(c.gu + (size_t)D * FFN2, D, FFN2, (bf16_t*)(c.ws + WS_WGU + WGU_L), 1, it - CI_GU1, tile, lane);
    else conv_item(c.down + (size_t)FFH * D, FFH, D, (bf16_t*)(c.ws + WS_WDOWN + WDOWN_L), 0, it - CI_DOWN1, tile, lane);
}
__device__ __forceinline__ void conv_desc(const ConvCtx& c, int it, int lane, const float*& src, int& N, bf16_t*& dst, int& K) {
    const float* W; bf16_t* WT; int map = 0, li;
    if (it < CI_EVOUT) { const int g = it >> 6; W = c.pool + (size_t)g * 512 * 512; K = 512; N = 512; WT = (bf16_t*)(c.ws + WS_WPOOL) + (size_t)g * 512 * 512; li = it & 63; }
    else if (it < CI_GU0) { W = c.evout; K = D; N = D; WT = (bf16_t*)(c.ws + WS_WEVOUT); li = it - CI_EVOUT; }
    else if (it < CI_DOWN0) { W = c.gu; K = D; N = FFN2; WT = (bf16_t*)(c.ws + WS_WGU); map = 1; li = it - CI_GU0; }
    else if (it < CI_ODIN) { W = c.down; K = FFH; N = D; WT = (bf16_t*)(c.ws + WS_WDOWN); li = it - CI_DOWN0; }
    else if (it < CI_QB) { W = c.odin; K = D; N = ODIN; WT = (bf16_t*)(c.ws + WS_WODIN); map = 2; li = it - CI_ODIN; }
    else if (it < CI_KVB) { W = c.qb; K = 1024; N = QMW; WT = (bf16_t*)(c.ws + WS_WQB); li = it - CI_QB; }
    else if (it < CI_ODOUT) { W = c.kvb; K = 512; N = KVW; WT = (bf16_t*)(c.ws + WS_WKVB); li = it - CI_KVB; }
    else if (it < CI_GU1) { W = c.odout; K = D; N = D; WT = (bf16_t*)(c.ws + WS_WODOUT); li = it - CI_ODOUT; }
    else if (it < CI_DOWN1) { W = c.gu + (size_t)D * FFN2; K = D; N = FFN2; WT = (bf16_t*)(c.ws + WS_WGU + WGU_L); map = 1; li = it - CI_GU1; }
    else { W = c.down + (size_t)FFH * D; K = FFH; N = D; WT = (bf16_t*)(c.ws + WS_WDOWN + WDOWN_L); li = it - CI_DOWN1; }
    const int nnb = N / 64, kq = lane >> 4, nq = lane & 15, ch = lane & 7;
    const int kc = li / nnb, nb = li - kc * nnb, n0 = nb * 64;
    int dr = n0;
    if (map == 1) { const int isu = n0 >= FFH, j = isu ? n0 - FFH : n0; dr = 256 * (j >> 7) + (isu ? 128 : 0) + (j & 127); }
    else if (map == 2) { dr = n0 < 3584 ? n0 : (n0 < 3648 ? OC_KR + (n0 - 3584) : n0 - 64); }
    src = W + (size_t)(kc * 64 + 16 * kq) * N + n0 + 4 * nq;
    dst = WT + (size_t)dr * K + kc * 64 + 8 * ch;
}
template <bool ADAPT = false>
__device__ __forceinline__ void conv_range(const ConvCtx& c, int lo, int hi, int hw, int nh, int wave, LAS unsigned char* L, unsigned* done_cnt = nullptr, unsigned done_need = 0u, int* stop_slot = nullptr) {
    const int lane = launder_tid(wave) & 63; LAS unsigned char* tile = L + wave * 8192;
    const int kq = lane >> 4, nq = lane & 15, rn = lane >> 3, ch = lane & 7, sw = nq & 7, stride = nh * 8;
    int it = lo + hw * 8 + wave; if (it >= hi) { if (ADAPT && lane == 0) __hip_atomic_store(stop_slot, hi, __ATOMIC_RELAXED, __HIP_MEMORY_SCOPE_AGENT); return; }
    const float* src; bf16_t* dst; int N, K; f32x4 v[16];
    conv_desc(c, it, lane, src, N, dst, K);
#pragma unroll
    for (int i = 0; i < 16; ++i) v[i] = __builtin_nontemporal_load((const f32x4*)(src + (size_t)i * N));
    for (;;) {
        const int nx = it + stride; const bool more = nx < hi;
        unsigned dn = 0u; if (ADAPT) dn = __hip_atomic_load(done_cnt, __ATOMIC_RELAXED, __HIP_MEMORY_SCOPE_AGENT);
        const float* src2 = src; bf16_t* dst2 = dst; int N2 = N, K2 = K; f32x4 w[16];
        if (more) { conv_desc(c, nx, lane, src2, N2, dst2, K2);
#pragma unroll
            for (int i = 0; i < 16; ++i) w[i] = __builtin_nontemporal_load((const f32x4*)(src2 + (size_t)i * N2)); }
#pragma unroll
        for (int j = 0; j < 4; ++j) {
            u32x4 c0, c1;
            c0.x = cvt_pk_bf16(v[0][j], v[1][j]); c0.y = cvt_pk_bf16(v[2][j], v[3][j]); c0.z = cvt_pk_bf16(v[4][j], v[5][j]); c0.w = cvt_pk_bf16(v[6][j], v[7][j]);
            c1.x = cvt_pk_bf16(v[8][j], v[9][j]); c1.y = cvt_pk_bf16(v[10][j], v[11][j]); c1.z = cvt_pk_bf16(v[12][j], v[13][j]); c1.w = cvt_pk_bf16(v[14][j], v[15][j]);
            const int n = 4 * nq + j;
            *(LAS u32x4*)(tile + n * 128 + (((2 * kq) ^ sw) << 4)) = c0; *(LAS u32x4*)(tile + n * 128 + (((2 * kq + 1) ^ sw) << 4)) = c1;
        }
        LDS_WAIT(); asm volatile("" ::: "memory");
#pragma unroll
        for (int t = 0; t < 8; ++t) { const int n = rn + 8 * t; const u32x4 o = *(const LAS u32x4*)(tile + n * 128 + ((ch ^ ((n >> 2) & 7)) << 4)); *(u32x4*)(dst + (size_t)n * K) = o; }
        LDS_WAIT(); asm volatile("" ::: "memory");
        if (!more) { if (ADAPT && lane == 0) __hip_atomic_store(stop_slot, hi, __ATOMIC_RELAXED, __HIP_MEMORY_SCOPE_AGENT); break; }
        if (ADAPT && (unsigned)__builtin_amdgcn_readfirstlane((int)dn) >= done_need) { if (lane == 0) __hip_atomic_store(stop_slot, nx, __ATOMIC_RELAXED, __HIP_MEMORY_SCOPE_AGENT); break; }
#pragma unroll
        for (int i = 0; i < 16; ++i) v[i] = w[i];
        it = nx; src = src2; dst = dst2; N = N2; K = K2;
    }
}

__device__ __forceinline__ void conv_catchup(const ConvCtx& c, int hi, int nslots, const int* stop, int gw, int ngw, int wave, LAS unsigned char* L) {
    const int lane = launder_tid(wave) & 63; LAS unsigned char* tile = L + wave * 8192;
    const int k = gw % nslots, j = gw / nslots, nj = ngw / nslots;
    for (int it = __builtin_amdgcn_readfirstlane(__hip_atomic_load(stop + k, __ATOMIC_RELAXED, __HIP_MEMORY_SCOPE_AGENT)) + j * nslots; it < hi; it += nj * nslots) conv_list_item(c, it, tile, lane);
}

template <int W>
__device__ __forceinline__ void pool_run(const bf16_t* __restrict__ Z, bf16_t* __restrict__ PA, int seg0, int segl, int t0, int g, int lane) {
    constexpr int HW = W / 2, NR = 8 + W - 1;
    const bf16_t* zc = Z + (size_t)seg0 * EV_IN + g * 512 + lane * 8;
    u32x4 rb[NR];
#pragma unroll
    for (int i = 0; i < NR; ++i) { int rr = t0 - HW + i; rr = min(max(rr, 0), segl - 1); rb[i] = *(const u32x4*)(zc + (size_t)rr * EV_IN); }
#pragma unroll
    for (int o = 0; o < 8; ++o) { const int t = t0 + o;
        float s[8];
#pragma unroll
        for (int e = 0; e < 8; ++e) s[e] = 0.f;
#pragma unroll
        for (int k = 0; k < W; ++k) { const int rr = t - HW + k; const float wgt = (rr >= 0 && rr < segl) ? 1.f : 0.f; const u32x4 q = rb[o + k];
            s[0] = fmaf(wgt, bf_lo(q.x), s[0]); s[1] = fmaf(wgt, bf_hi(q.x), s[1]); s[2] = fmaf(wgt, bf_lo(q.y), s[2]); s[3] = fmaf(wgt, bf_hi(q.y), s[3]);
            s[4] = fmaf(wgt, bf_lo(q.z), s[4]); s[5] = fmaf(wgt, bf_hi(q.z), s[5]); s[6] = fmaf(wgt, bf_lo(q.w), s[6]); s[7] = fmaf(wgt, bf_hi(q.w), s[7]); }
        const int wlo = max(t - HW, 0), whi = min(t - HW + W, segl); const float inv = 1.0f / (float)(whi - wlo);
        const u32x4 q = rb[o + HW];
        u32x4 r; r.x = cvt_pk_bf16(s[0] * inv - bf_lo(q.x), s[1] * inv - bf_hi(q.x)); r.y = cvt_pk_bf16(s[2] * inv - bf_lo(q.y), s[3] * inv - bf_hi(q.y));
        r.z = cvt_pk_bf16(s[4] * inv - bf_lo(q.z), s[5] * inv - bf_hi(q.z)); r.w = cvt_pk_bf16(s[6] * inv - bf_lo(q.w), s[7] * inv - bf_hi(q.w));
        *(u32x4*)(PA + (size_t)(seg0 + t) * 2048 + g * 512 + lane * 8) = r; }
}

__device__ __forceinline__ void norm_coop_x(const bf16_t* __restrict__ XB, bf16_t* __restrict__ H, const float* __restrict__ gvec, const float* __restrict__ modl  ,
                                            int wg, int nwg, int wave, LAS float* red) {
    const int lane = launder_tid(wave) & 63, c = 512 * wave + 8 * lane;
    for (int chunk = wg; chunk < NB * SEQ / 64; chunk += nwg) {
        const int b = chunk >> 5;
        const float* shp = modl + (size_t)b * MODW + c; const float* scp = shp + D;
        float A[8], Bc[8];
        { const f32x4 g0 = *(const f32x4*)(gvec + c), g1 = *(const f32x4*)(gvec + c + 4), s10 = *(const f32x4*)scp, s11 = *(const f32x4*)(scp + 4), s00 = *(const f32x4*)shp, s01 = *(const f32x4*)(shp + 4);
#pragma unroll
          for (int e = 0; e < 4; ++e) { A[e] = g0[e] * (s10[e] + 1.0f); A[4 + e] = g1[e] * (s11[e] + 1.0f); Bc[e] = s00[e]; Bc[4 + e] = s01[e]; } }
        const size_t row0 = (size_t)xrow(chunk * 64);
#pragma unroll 1
        for (int g = 0; g < 4; ++g) {
            const bf16_t* src = XB + (row0 + g * 16) * D + c;
            u32x4 v[16]; float ps[16];
#pragma unroll
            for (int r = 0; r < 16; ++r) v[r] = *(const u32x4*)(src + (size_t)r * D);
#pragma unroll
            for (int r = 0; r < 16; ++r) { const float a0 = bf_lo(v[r].x), a1 = bf_hi(v[r].x), a2 = bf_lo(v[r].y), a3 = bf_hi(v[r].y), a4 = bf_lo(v[r].z), a5 = bf_hi(v[r].z), a6 = bf_lo(v[r].w), a7 = bf_hi(v[r].w);
                ps[r] = wave_sum((a0 * a0 + a1 * a1) + (a2 * a2 + a3 * a3) + (a4 * a4 + a5 * a5) + (a6 * a6 + a7 * a7)); }
            LAS float* rb = red + (g & 1) * 128;
            if (lane < 16) { float mine = ps[0];
#pragma unroll
                for (int r = 1; r < 16; ++r) mine = (lane == r) ? ps[r] : mine;
                rb[lane * 8 + wave] = mine; }
            LDS_WAIT(); __syncthreads();
            bf16_t* dst = H + (row0 + g * 16) * D + c;
#pragma unroll
            for (int r = 0; r < 16; ++r) { const f32x4 t0 = *(const LAS f32x4*)(rb + r * 8), t1 = *(const LAS f32x4*)(rb + r * 8 + 4);
                const float tot = ((t0[0] + t0[1]) + (t0[2] + t0[3])) + ((t1[0] + t1[1]) + (t1[2] + t1[3]));
                const float rstd = 1.0f / sqrtf(tot * (1.0f / D) + EPS);
                const float x0 = bf_lo(v[r].x), x1 = bf_hi(v[r].x), x2 = bf_lo(v[r].y), x3 = bf_hi(v[r].y), x4 = bf_lo(v[r].z), x5 = bf_hi(v[r].z), x6 = bf_lo(v[r].w), x7 = bf_hi(v[r].w);
                u32x4 w; w.x = cvt_pk_bf16(x0 * rstd * A[0] + Bc[0], x1 * rstd * A[1] + Bc[1]); w.y = cvt_pk_bf16(x2 * rstd * A[2] + Bc[2], x3 * rstd * A[3] + Bc[3]);
                w.z = cvt_pk_bf16(x4 * rstd * A[4] + Bc[4], x5 * rstd * A[5] + Bc[5]); w.w = cvt_pk_bf16(x6 * rstd * A[6] + Bc[6], x7 * rstd * A[7] + Bc[7]);
                *(u32x4*)(dst + (size_t)r * D) = w; }
        }
        __syncthreads();
    }
}

__global__ void __launch_bounds__(512, 2) trunk_fwd(Args args) {
    extern __shared__ __attribute__((aligned(16))) unsigned char lds[];
    LAS unsigned char* L = (LAS unsigned char*)lds;
    volatile LAS unsigned* MISC = (volatile LAS unsigned*)(L + MISC_OFF);
    const int wave = __builtin_amdgcn_readfirstlane((int)threadIdx.x >> 6);
    const int G = gridDim.x, bx = blockIdx.x, vcu = (G % 8 == 0) ? (bx % 8) * (G / 8) + bx / 8 : bx;
    const int gw = vcu * 8 + wave, NGW = G * 8;
    unsigned char* ws = args.ws;
    unsigned* ctl = (unsigned*)(ws + WS_CTL);
    float* MOD = (float*)(ws + WS_MOD);
    float* ROPEM = (float*)(ws + WS_ROPEM); float* ROPEG = (float*)(ws + WS_ROPEG);
    bf16_t* W_EVIN = (bf16_t*)(ws + WS_WEVIN); bf16_t* W_EVOUT = (bf16_t*)(ws + WS_WEVOUT); bf16_t* W_POOL = (bf16_t*)(ws + WS_WPOOL); bf16_t* W_SGU = (bf16_t*)(ws + WS_WSGU);
    bf16_t* W_ODIN = (bf16_t*)(ws + WS_WODIN); bf16_t* W_QB = (bf16_t*)(ws + WS_WQB); bf16_t* W_KVB = (bf16_t*)(ws + WS_WKVB); bf16_t* W_ODOUT = (bf16_t*)(ws + WS_WODOUT);
    float* X = (float*)(ws + WS_X); bf16_t* H = (bf16_t*)(ws + WS_H); bf16_t* Z = (bf16_t*)(ws + WS_Z); bf16_t* PA = (bf16_t*)(ws + WS_PA); bf16_t* YC = (bf16_t*)(ws + WS_YC);
    bf16_t* XB = (bf16_t*)(ws + WS_XB); float* PART = (float*)(ws + WS_PART); bf16_t* HID = (bf16_t*)(ws + WS_HID); bf16_t* QM = (bf16_t*)(ws + WS_QM); bf16_t* KVM = (bf16_t*)(ws + WS_KVM);

    const ConvCtx cc{args.in[I_POOLW], args.in[I_EVOUT], args.in[I_WGU], args.in[I_WDOWN], args.in[I_ODIN], args.in[I_WQB], args.in[I_WKVB], args.in[I_ODOUT], ws};
    for (int u = threadIdx.x; u < (LDS_BYTES - RING_BYTES) / 4; u += 512) ((LAS unsigned*)(L + RING_BYTES))[u] = 0u;
    __syncthreads();
#if MK_N_LAUNCHES == 1
    XcdBarrier bar = xcd_barrier_post(ctl + CW_BAR, MISC + 8);
#define GRID_BAR() xcd_barrier(bar)
#else
#define GRID_BAR() do {} while (0)
#endif
    const int lo = args.ph_lo, hi = args.ph_hi;
#define IN(k) (lo <= (k) && (k) < hi)
#define SEAM(k) do { if (IN(k) && IN((k) + 1)) GRID_BAR(); } while (0)

    if (IN(0)) { const int tid = launder_tid(wave), lane = tid & 63; (void)tid; (void)lane;
        for (int s01 = 0; s01 < 2; ++s01) {
        if ((s01 == 0) == (((bx >> 3) & 1) == 0)) {
            LAS float* red = (LAS float*)L;
            for (int item = vcu; item < 256; item += G) {
                const int layer = item >> 7, cb = item & 127, col0 = cb * 192 + 3 * lane;
                const float* Wl = args.in[I_MODW] + (size_t)layer * D * MODW;
                float acc[9][3];
#pragma unroll
                for (int r = 0; r < 9; ++r) { acc[r][0] = 0.f; acc[r][1] = 0.f; acc[r][2] = 0.f; }
                for (int ch = 0; ch < 8; ++ch) {
                    const int k0 = wave * 512 + ch * 64;
                    float sv[9];
#pragma unroll
                    for (int r = 0; r < 9; ++r) { const float cv = (r < 8) ? args.in[I_C][r * D + k0 + lane] : args.in[I_CCTX][k0 + lane]; sv[r] = cv / (1.0f + expf(-cv)); }
                    const float* wp = Wl + (size_t)k0 * MODW + col0;
#pragma unroll 16
                    for (int kk = 0; kk < 64; ++kk) {
                        const float w0 = __builtin_nontemporal_load(wp + (size_t)kk * MODW), w1 = __builtin_nontemporal_load(wp + (size_t)kk * MODW + 1), w2 = __builtin_nontemporal_load(wp + (size_t)kk * MODW + 2);
#pragma unroll
                        for (int r = 0; r < 9; ++r) { const float s = __builtin_bit_cast(float, __builtin_amdgcn_readlane(__builtin_bit_cast(int, sv[r]), kk)); acc[r][0] = fmaf(s, w0, acc[r][0]); acc[r][1] = fmaf(s, w1, acc[r][1]); acc[r][2] = fmaf(s, w2, acc[r][2]); }
                    }
                }
#pragma unroll
                for (int r = 0; r < 9; ++r)
#pragma unroll
                    for (int e = 0; e < 3; ++e) red[(wave * 27 + r * 3 + e) * 64 + lane] = acc[r][e];
                __syncthreads();
                for (int o = tid; o < 27 * 64; o += 512) {
                    float s = 0.f;
#pragma unroll
                    for (int w = 0; w < 8; ++w) s += red[w * 27 * 64 + o];
                    const int j = o >> 6, ln = o & 63, r = j / 3, e = j % 3, col = cb * 192 + 3 * ln + e;
                    MOD[((size_t)layer * 9 + r) * MODW + col] = s + args.in[I_MODB][layer * MODW + col];
                }
                __syncthreads();
            }
        } else {
          LAS unsigned char* tile = L + wave * 8192;
          for (int it = gw; it < (D / 64) * (EV_IN / 64); it += NGW) conv_item(args.in[I_EVIN], D, EV_IN, W_EVIN, 0, it, tile, lane);
          for (int it = CV_P0A_LO + gw; it < CV_P0A_HI; it += NGW) conv_list_item(cc, it, tile, lane);
          for (int it = CV_P0B_LO + gw; it < CV_P0B_HI; it += NGW) conv_list_item(cc, it, tile, lane);
          __syncthreads();
        } }
        for (int i = gw * 64 + lane; i < 2048 * 96; i += NGW * 64) {
            const int t = i / 96, f = i % 96; const float row = (float)(t >> 6), colp = (float)(t & 63);
            if (f < 32) { const int ff = f & 15; const float inv = powf(10000.0f, -(float)ff / 16.0f); const float ang = (f < 16 ? row : colp) * inv; ROPEM[t * 32 + f] = cosf(ang); ROPEM[2048 * 32 + t * 32 + f] = sinf(ang); }
            else { const int f2 = f - 32, ff = f2 & 31; const float inv = powf(10000.0f, -(float)ff / 32.0f); const float ang = (f2 < 32 ? row : colp) * inv; ROPEG[t * 64 + f2] = cosf(ang); ROPEG[2048 * 64 + t * 64 + f2] = sinf(ang); }
        }
        for (int i = gw * 64 + lane; i < 4 * 128 * 128; i += NGW * 64) W_SGU[i] = f2bf(args.in[I_SGUWS][i]);
        for (int i = gw * 64 + lane; i < (ODIN_P - ODIN) * D / 8; i += NGW * 64) *(u32x4*)(W_ODIN + (size_t)ODIN * D + (size_t)i * 8) = (u32x4){0u, 0u, 0u, 0u};
    }
    SEAM(0);

#define NORM_PHASE(LAYER, WHICH, FROM_INPUT, XONLY) do { \
        const float* gvec = args.in[(WHICH) == 0 ? I_N1G : I_N2G] + (LAYER) * D; \
        const int nrows = (XONLY) ? NB * SEQ : MALL; \
        for (int idx = gw; idx < nrows; idx += NGW) { \
            const int R = (XONLY) ? xrow(idx) : idx; const int b = R / LT, j = R % LT; const int mr = j < CTXL ? 8 : b; \
            const float* srow = (FROM_INPUT) ? (j < CTXL ? args.in[I_CTX] + ((size_t)b * CTXL + j) * D : args.in[I_X] + ((size_t)b * SEQ + (j - CTXL)) * D) : X + (size_t)R * D; \
            const float* shp = MOD + ((size_t)(LAYER) * 9 + mr) * MODW + (WHICH) * 3 * D; const float* scp = shp + D; \
            f32x4 v[16]; float ss = 0.f; \
            _Pragma("unroll") for (int q = 0; q < 16; ++q) { v[q] = *(const f32x4*)(srow + (q * 64 + lane) * 4); ss += (v[q].x * v[q].x + v[q].y * v[q].y) + (v[q].z * v[q].z + v[q].w * v[q].w); } \
            const float rstd = 1.0f / sqrtf(wave_sum(ss) * (1.0f / D) + EPS); \
            bf16_t* hrow = H + (size_t)R * D; \
            _Pragma("unroll") for (int q = 0; q < 16; ++q) { const int c = (q * 64 + lane) * 4; const f32x4 gg = *(const f32x4*)(gvec + c), s1 = *(const f32x4*)(scp + c), s0 = *(const f32x4*)(shp + c); \
                const f32x4 y = v[q] * rstd * gg * (s1 + 1.0f) + s0; u32x2 w; w.x = cvt_pk_bf16(y.x, y.y); w.y = cvt_pk_bf16(y.z, y.w); *(u32x2*)(hrow + c) = w; } \
        } } while (0)

#define NORM_PHASE_B(LAYER, WHICH, XONLY) do { \
        const float* gvec = args.in[(WHICH) == 0 ? I_N1G : I_N2G] + (LAYER) * D; \
        const int nrows = (XONLY) ? NB * SEQ : MALL; \
        for (int idx = gw; idx < nrows; idx += NGW) { \
            const int R = (XONLY) ? xrow(idx) : idx; const int b = R / LT, j = R % LT; const int mr = j < CTXL ? 8 : b; \
            const bf16_t* srow = XB + (size_t)R * D; \
            const float* shp = MOD + ((size_t)(LAYER) * 9 + mr) * MODW + (WHICH) * 3 * D; const float* scp = shp + D; \
            u32x4 v[8]; float ss = 0.f; \
            _Pragma("unroll") for (int q = 0; q < 8; ++q) { v[q] = *(const u32x4*)(srow + (q * 64 + lane) * 8); \
                const float a0 = bf_lo(v[q].x), a1 = bf_hi(v[q].x), a2 = bf_lo(v[q].y), a3 = bf_hi(v[q].y), a4 = bf_lo(v[q].z), a5 = bf_hi(v[q].z), a6 = bf_lo(v[q].w), a7 = bf_hi(v[q].w); \
                ss += (a0 * a0 + a1 * a1) + (a2 * a2 + a3 * a3) + (a4 * a4 + a5 * a5) + (a6 * a6 + a7 * a7); } \
            const float rstd = 1.0f / sqrtf(wave_sum(ss) * (1.0f / D) + EPS); \
            bf16_t* hrow = H + (size_t)R * D; \
            _Pragma("unroll") for (int q = 0; q < 8; ++q) { const int c = (q * 64 + lane) * 8; \
                const f32x4 g0 = *(const f32x4*)(gvec + c), g1 = *(const f32x4*)(gvec + c + 4), s10 = *(const f32x4*)(scp + c), s11 = *(const f32x4*)(scp + c + 4), s00 = *(const f32x4*)(shp + c), s01 = *(const f32x4*)(shp + c + 4); \
                const f32x4 x0 = (f32x4){bf_lo(v[q].x), bf_hi(v[q].x), bf_lo(v[q].y), bf_hi(v[q].y)}, x1 = (f32x4){bf_lo(v[q].z), bf_hi(v[q].z), bf_lo(v[q].w), bf_hi(v[q].w)}; \
                const f32x4 y0 = x0 * rstd * g0 * (s10 + 1.0f) + s00, y1 = x1 * rstd * g1 * (s11 + 1.0f) + s01; \
                u32x4 w; w.x = cvt_pk_bf16(y0.x, y0.y); w.y = cvt_pk_bf16(y0.z, y0.w); w.z = cvt_pk_bf16(y1.x, y1.y); w.w = cvt_pk_bf16(y1.z, y1.w); *(u32x4*)(hrow + c) = w; } \
        } } while (0)

#define NORM_CTX_COMBINE(LAYER, WHICH, FROM_INPUT, GATEP, STORE_X) do { \
        const float* gvec = args.in[(WHICH) == 0 ? I_N1G : I_N2G] + (LAYER) * D; \
        const float* shp = MOD + ((size_t)(LAYER) * 9 + 8) * MODW + (WHICH) * 3 * D; const float* scp = shp + D; \
        for (int cr = gw; cr < NB * CTXL; cr += NGW) { \
            const int b = cr >> 8, j = cr & 255; const size_t R = (size_t)b * LT + j; \
            const float* srow = (FROM_INPUT) ? args.in[I_CTX] + (size_t)cr * D : X + R * D; \
            const float* p0 = PART + (size_t)cr * D; const float* p1 = p0 + (size_t)NB * CTXL * D; \
            f32x4 v[16]; float ss = 0.f; \
            _Pragma("unroll") for (int q = 0; q < 16; ++q) { const int c = (q * 64 + lane) * 4; \
                v[q] = *(const f32x4*)(srow + c) + *(const f32x4*)((GATEP) + c) * (*(const f32x4*)(p0 + c) + *(const f32x4*)(p1 + c)); \
                if (STORE_X) *(f32x4*)(X + R * D + c) = v[q]; \
                ss += (v[q].x * v[q].x + v[q].y * v[q].y) + (v[q].z * v[q].z + v[q].w * v[q].w); \
                if ((q & 3) == 3) asm volatile("" ::: "memory"); } \
            const float rstd = 1.0f / sqrtf(wave_sum(ss) * (1.0f / D) + EPS); \
            bf16_t* hrow = H + R * D; \
            _Pragma("unroll") for (int q = 0; q < 16; ++q) { const int c = (q * 64 + lane) * 4; const f32x4 gg = *(const f32x4*)(gvec + c), s1 = *(const f32x4*)(scp + c), s0 = *(const f32x4*)(shp + c); \
                const f32x4 y = v[q] * rstd * gg * (s1 + 1.0f) + s0; u32x2 w; w.x = cvt_pk_bf16(y.x, y.y); w.y = cvt_pk_bf16(y.z, y.w); *(u32x2*)(hrow + c) = w; } \
        } } while (0)

    if (IN(1)) { const int tid = launder_tid(wave), lane = tid & 63; (void)tid; (void)lane; NORM_PHASE(0, 0, true, false); }
    SEAM(1);

    if (IN(2)) {
        if (bx < G - NH_P2) { pg8::Gemm g{H, W_EVIN, D, D, D, 30, 0}; pg8::OrderAll S{EV_IN / 256, G - NH_P2, bx}; pg8::EpiBf16 E{Z, EV_IN, 8};
            pg8::gemm_phase(L, g, S, E, wave); }
        else conv_range(cc, CV_P2_LO, CV_P2_HI, bx - (G - NH_P2), NH_P2, wave, L);
    }
    SEAM(2);

    if (IN(3)) { const int tid = launder_tid(wave), lane = tid & 63; (void)tid; (void)lane;
        {
            constexpr int nitems = (MALL / 8) * 4; const int nheavy = (G >= 128 ? 64 : 0) * 8, nlight = NGW - nheavy, rest = nitems - 2 * nheavy;
            const int it_lo = gw < nheavy ? 2 * gw : 2 * nheavy + (int)((long)(gw - nheavy) * rest / nlight), it_hi = gw < nheavy ? 2 * gw + 2 : 2 * nheavy + (int)((long)(gw - nheavy + 1) * rest / nlight);
            for (int it = it_lo; it < it_hi; ++it) {
                const int g = it & 3, R0 = (it >> 2) * 8;
                const int b = R0 / LT, j = R0 % LT; const int seg0 = j < CTXL ? b * LT : b * LT + CTXL, segl = j < CTXL ? CTXL : SEQ, t0 = R0 - seg0;
                if (g == 0) pool_run<2>(Z, PA, seg0, segl, t0, 0, lane); else if (g == 1) pool_run<4>(Z, PA, seg0, segl, t0, 1, lane);
                else if (g == 2) pool_run<8>(Z, PA, seg0, segl, t0, 2, lane); else pool_run<16>(Z, PA, seg0, segl, t0, 3, lane);
            }
        }
        {
            const int wp = wave & 3, wd = wave >> 2, r32 = lane & 31, hl = lane >> 5;
            for (int un = vcu; un < (MALL / 128) * 4; un += G) {
                const int ch = un >> 2, h = un & 3, R0 = ch * 128;
                bf16x8 pa[8];
                { const bf16_t* wsp = W_SGU + ((size_t)h * 128 + 32 * wp + r32) * 128 + 8 * hl;
#pragma unroll
                  for (int ks = 0; ks < 8; ++ks) pa[ks] = *(const bf16x8*)(wsp + 16 * ks); }
                { const int q = tid >> 2, qt = tid & 3;
                  const bf16_t* vp = Z + (size_t)(R0 + q) * EV_IN + 4096 + h * 512 + qt * 128;
                  u32x4 vv[16]; float ss = 0.f;
#pragma unroll
                  for (int i = 0; i < 16; ++i) { vv[i] = *(const u32x4*)(vp + i * 8);
                      const float a0 = bf_lo(vv[i].x), a1 = bf_hi(vv[i].x), a2 = bf_lo(vv[i].y), a3 = bf_hi(vv[i].y), a4 = bf_lo(vv[i].z), a5 = bf_hi(vv[i].z), a6 = bf_lo(vv[i].w), a7 = bf_hi(vv[i].w);
                      ss += (a0 * a0 + a1 * a1) + (a2 * a2 + a3 * a3) + (a4 * a4 + a5 * a5) + (a6 * a6 + a7 * a7); }
                  ss += __shfl_xor(ss, 1); ss += __shfl_xor(ss, 2);
                  const float rstd = 1.0f / sqrtf(ss * (1.0f / 512.0f) + EPS);
                  const float* ng = args.in[I_SGUNG] + h * 512 + qt * 128;
                  LAS unsigned char* tile = L + (qt * 2 + (q >> 6)) * 16384;
#pragma unroll
                  for (int i = 0; i < 16; ++i) { const f32x4 g0 = *(const f32x4*)(ng + i * 8), g1 = *(const f32x4*)(ng + i * 8 + 4);
                      u32x4 o; o.x = cvt_pk_bf16(bf_lo(vv[i].x) * rstd * g0.x, bf_hi(vv[i].x) * rstd * g0.y); o.y = cvt_pk_bf16(bf_lo(vv[i].y) * rstd * g0.z, bf_hi(vv[i].y) * rstd * g0.w);
                      o.z = cvt_pk_bf16(bf_lo(vv[i].z) * rstd * g1.x, bf_hi(vv[i].z) * rstd * g1.y); o.w = cvt_pk_bf16(bf_lo(vv[i].w) * rstd * g1.z, bf_hi(vv[i].w) * rstd * g1.w);
                      *(LAS u32x4*)(tile + att::v_st(q & 63, i * 8)) = o; } }
                __syncthreads();
                const float* bsp = args.in[I_SGUB] + h * 128 + 32 * wp;
#pragma unroll
                for (int dbi = 0; dbi < 2; ++dbi) {
                    const int db = 2 * wd + dbi;
                    const float bb = bsp[r32]; const size_t ro = (size_t)(R0 + 32 * wp + r32);
                    const bf16_t* up = Z + ro * EV_IN + 2048 + h * 512 + db * 128 + 4 * hl; bf16_t* yp = YC + ro * D + 2048 + h * 512 + db * 128 + 4 * hl;
                    u32x2 uu[4][4];
#pragma unroll
                    for (int d0 = 0; d0 < 4; ++d0)
#pragma unroll
                        for (int g = 0; g < 4; ++g) uu[d0][g] = *(const u32x2*)(up + d0 * 32 + 8 * g);
                    f32x16 o[4] = {};
                    const int vb = (int)(uintptr_t)(lds + (db * 2) * 16384) + att::v_rd_base(lane);
                    att::pvT_d0(o, vb, pa[0], pa[1], pa[2], pa[3]);
                    att::pvT_d0(o, vb + 16384, pa[4], pa[5], pa[6], pa[7]);
                    asm volatile("" ::: "memory");
#pragma unroll
                    for (int d0 = 0; d0 < 4; ++d0)
#pragma unroll
                        for (int g = 0; g < 4; ++g) { const u32x2 u2 = uu[d0][g];
                            u32x2 w; w.x = cvt_pk_bf16(bf_lo(u2.x) * (o[d0][4 * g + 0] + bb), bf_hi(u2.x) * (o[d0][4 * g + 1] + bb)); w.y = cvt_pk_bf16(bf_lo(u2.y) * (o[d0][4 * g + 2] + bb), bf_hi(u2.y) * (o[d0][4 * g + 3] + bb));
                            *(u32x2*)(yp + d0 * 32 + 8 * g) = w; }
                }
                __syncthreads();
            }
        }
    }
    SEAM(3);

    if (IN(4)) {
        pg8::Gemm g{PA, W_POOL, 2048, 512, 512, 1, 512}; pg8::OrderAll S{8, G, bx}; pg8::EpiPool E{YC, D, args.in[I_POOLS]};
        pg8::gemm_phase(L, g, S, E, wave);
    }
    SEAM(4);

    if (IN(5)) {
        pg8::Gemm g{YC, W_EVOUT, D, D, D, 30, 0}; pg8::OrderXSplitCtx<8> S{G, bx, D / 64}; pg8::EpiResGate E{X, args.in[I_X], args.in[I_CTX], MOD + 2 * D, true, XB, PART};
        pg8::gemm_phase(L, g, S, E, wave);
    }
    SEAM(5);

    if (IN(6)) { const int tid = launder_tid(wave), lane = tid & 63; (void)tid; (void)lane; norm_coop_x(XB, H, args.in[I_N2G], MOD + 3 * D, vcu, G, wave, (LAS float*)L); NORM_CTX_COMBINE(0, 1, true, MOD + (size_t)8 * MODW + 2 * D, true); }
    SEAM(6);

    if (IN(7)) {
        if (bx < G - NH_P7) { pg8::Gemm g{H, (const bf16_t*)(ws + WS_WGU), D, D, D, 30, 0}; pg8::OrderAll S{FFN2 / 256, G - NH_P7, bx}; pg8::EpiSwiGLU E{HID, FFH};
            pg8::gemm_phase(L, g, S, E, wave);
            if (threadIdx.x == 0) __hip_atomic_fetch_add(ctl + CW_HDONE, 1u, __ATOMIC_RELAXED, __HIP_MEMORY_SCOPE_AGENT); }
        else { conv_range(cc, CV_P7_LO, CV_P7_HI, bx - (G - NH_P7), NH_P7, wave, L);
               conv_range<true>(cc, CV_OPT_LO, CV_OPT_HI, bx - (G - NH_P7), NH_P7, wave, L, ctl + CW_HDONE, (unsigned)(G - NH_P7), (int*)(ctl + CW_HSTOP) + (bx - (G - NH_P7)) * 8 + wave); }
    }
    SEAM(7);

    if (IN(8)) {
        pg8::Gemm g{HID, (const bf16_t*)(ws + WS_WDOWN), FFH, FFH, FFH, 30, 0}; pg8::OrderXSplitCtx<8> S{G, bx, FFH / 64};     pg8::EpiResGate E{X, nullptr, nullptr, MOD + 5 * D, false, XB, PART};
        pg8::gemm_phase(L, g, S, E, wave);
    }
    SEAM(8);

    if (IN(9)) { const int tid = launder_tid(wave), lane = tid & 63; (void)tid; (void)lane; norm_coop_x(XB, H, args.in[I_N1G] + D, MOD + (size_t)9 * MODW, vcu, G, wave, (LAS float*)L); NORM_CTX_COMBINE(1, 0, false, MOD + (size_t)8 * MODW + 5 * D, false); }
    SEAM(9);

    if (IN(10)) {
        pg8::Gemm g{H, W_ODIN, D, D, D, 30, 0}; pg8::OrderOdIn S{G, bx}; pg8::EpiBf16 E{Z, ODIN_P, 1 << 30};
        pg8::gemm_phase(L, g, S, E, wave);
    }
    SEAM(10);

    if (IN(11)) { const int tid = launder_tid(wave), lane = tid & 63; (void)tid;
        const float* cosG = ROPEG; const float* sinG = ROPEG + 2048 * 64; const float* cosM = ROPEM; const float* sinM = ROPEM + 2048 * 32;
        const int hh = lane >> 4, jj = lane & 15;
        float gqa[16]; { const float* gp = args.in[I_QAG] + lane * 16;
#pragma unroll
            for (int e = 0; e < 16; ++e) gqa[e] = gp[e]; }
        float gkva[8]; { const float* gp = args.in[I_KVAG] + lane * 8;
#pragma unroll
            for (int e = 0; e < 8; ++e) gkva[e] = gp[e]; }
        const f32x4 gq1 = *(const f32x4*)(args.in[I_QNG] + 4 * jj), gq2 = *(const f32x4*)(args.in[I_QNG] + 64 + 4 * jj);
        const f32x4 gk1 = *(const f32x4*)(args.in[I_KNG] + 4 * jj), gk2 = *(const f32x4*)(args.in[I_KNG] + 64 + 4 * jj);
        for (int R = gw; R < MALL; R += NGW) {
            const int j = R % LT; const bool isx = j >= CTXL; const int t = isx ? j - CTXL : 0;
            bf16_t* zr = Z + (size_t)R * ODIN_P;
            u32x4 cq0 = (u32x4){0u, 0u, 0u, 0u}, cq1 = cq0; u32x2 qa[4], qb[4];
            if (isx) { cq0 = *(const u32x4*)(zr + OC_CQ + lane * 16); cq1 = *(const u32x4*)(zr + OC_CQ + lane * 16 + 8);
#pragma unroll
                for (int it = 0; it < 4; ++it) { const bf16_t* hp = zr + OC_GQ + (it * 4 + hh) * 128 + 4 * jj; qa[it] = *(const u32x2*)hp; qb[it] = *(const u32x2*)(hp + 64); } }
            const u32x4 ckv = *(const u32x4*)(zr + OC_CKV + lane * 8);
            bf16_t* kp_ = zr + OC_GK + hh * 128 + 4 * jj;
            const u32x2 ka = *(const u32x2*)kp_, kb = *(const u32x2*)(kp_ + 64);
            f32x4 cs = (f32x4){1.f, 1.f, 1.f, 1.f}, sn = (f32x4){0.f, 0.f, 0.f, 0.f};
            if (isx) { cs = *(const f32x4*)(cosG + t * 64 + 4 * jj); sn = *(const f32x4*)(sinG + t * 64 + 4 * jj); }
            bf16_t* krp = zr + OC_KR; float kr1 = 0.f, kr2 = 0.f, kcs = 1.f, ksn = 0.f;
            if (isx && lane < 32) { kr1 = bf2f(krp[lane]); kr2 = bf2f(krp[lane + 32]); kcs = cosM[t * 32 + lane]; ksn = sinM[t * 32 + lane]; }
            if (isx) {
                { float f[16] = {bf_lo(cq0.x), bf_hi(cq0.x), bf_lo(cq0.y), bf_hi(cq0.y), bf_lo(cq0.z), bf_hi(cq0.z), bf_lo(cq0.w), bf_hi(cq0.w), bf_lo(cq1.x), bf_hi(cq1.x), bf_lo(cq1.y), bf_hi(cq1.y), bf_lo(cq1.z), bf_hi(cq1.z), bf_lo(cq1.w), bf_hi(cq1.w)};
                  float ss = 0.f;
#pragma unroll
                  for (int e = 0; e < 16; ++e) ss += f[e] * f[e];
                  const float rstd = 1.0f / sqrtf(wave_sum(ss) * (1.0f / 1024.0f) + EPS);
#pragma unroll
                  for (int e = 0; e < 16; ++e) f[e] = f[e] * rstd * gqa[e];
                  u32x4 o0, o1; o0.x = cvt_pk_bf16(f[0], f[1]); o0.y = cvt_pk_bf16(f[2], f[3]); o0.z = cvt_pk_bf16(f[4], f[5]); o0.w = cvt_pk_bf16(f[6], f[7]);
                  o1.x = cvt_pk_bf16(f[8], f[9]); o1.y = cvt_pk_bf16(f[10], f[11]); o1.z = cvt_pk_bf16(f[12], f[13]); o1.w = cvt_pk_bf16(f[14], f[15]);
                  *(u32x4*)(zr + OC_CQ + lane * 16) = o0; *(u32x4*)(zr + OC_CQ + lane * 16 + 8) = o1; }
#pragma unroll
                for (int it = 0; it < 4; ++it) { bf16_t* hp = zr + OC_GQ + (it * 4 + hh) * 128 + 4 * jj;
                    const float x1[4] = {bf_lo(qa[it].x), bf_hi(qa[it].x), bf_lo(qa[it].y), bf_hi(qa[it].y)}, x2[4] = {bf_lo(qb[it].x), bf_hi(qb[it].x), bf_lo(qb[it].y), bf_hi(qb[it].y)};
                    float ss = 0.f;
#pragma unroll
                    for (int e = 0; e < 4; ++e) ss += x1[e] * x1[e] + x2[e] * x2[e];
                    ss += __shfl_xor(ss, 1); ss += __shfl_xor(ss, 2); ss += __shfl_xor(ss, 4); ss += __shfl_xor(ss, 8);
                    const float rstd = 1.0f / sqrtf(ss * (1.0f / 128.0f) + EPS);
                    float y1[4], y2[4];
#pragma unroll
                    for (int e = 0; e < 4; ++e) { const float a1 = x1[e] * rstd * gq1[e], a2 = x2[e] * rstd * gq2[e]; y1[e] = a1 * cs[e] - a2 * sn[e]; y2[e] = a1 * sn[e] + a2 * cs[e]; }
                    u32x2 o1, o2; o1.x = cvt_pk_bf16(y1[0], y1[1]); o1.y = cvt_pk_bf16(y1[2], y1[3]); o2.x = cvt_pk_bf16(y2[0], y2[1]); o2.y = cvt_pk_bf16(y2[2], y2[3]);
                    *(u32x2*)hp = o1; *(u32x2*)(hp + 64) = o2; }
            }
            { float f[8] = {bf_lo(ckv.x), bf_hi(ckv.x), bf_lo(ckv.y), bf_hi(ckv.y), bf_lo(ckv.z), bf_hi(ckv.z), bf_lo(ckv.w), bf_hi(ckv.w)};
              float ss = 0.f;
#pragma unroll
              for (int e = 0; e < 8; ++e) ss += f[e] * f[e];
              const float rstd = 1.0f / sqrtf(wave_sum(ss) * (1.0f / 512.0f) + EPS);
#pragma unroll
              for (int e = 0; e < 8; ++e) f[e] = f[e] * rstd * gkva[e];
              u32x4 o; o.x = cvt_pk_bf16(f[0], f[1]); o.y = cvt_pk_bf16(f[2], f[3]); o.z = cvt_pk_bf16(f[4], f[5]); o.w = cvt_pk_bf16(f[6], f[7]);
              *(u32x4*)(zr + OC_CKV + lane * 8) = o; }
            { const float x1[4] = {bf_lo(ka.x), bf_hi(ka.x), bf_lo(ka.y), bf_hi(ka.y)}, x2[4] = {bf_lo(kb.x), bf_hi(kb.x), bf_lo(kb.y), bf_hi(kb.y)};
              float ss = 0.f;
#pragma unroll
              for (int e = 0; e < 4; ++e) ss += x1[e] * x1[e] + x2[e] * x2[e];
              ss += __shfl_xor(ss, 1); ss += __shfl_xor(ss, 2); ss += __shfl_xor(ss, 4); ss += __shfl_xor(ss, 8);
              const float rstd = 1.0f / sqrtf(ss * (1.0f / 128.0f) + EPS);
              float y1[4], y2[4];
#pragma unroll
              for (int e = 0; e < 4; ++e) { const float a1 = x1[e] * rstd * gk1[e], a2 = x2[e] * rstd * gk2[e]; y1[e] = a1 * cs[e] - a2 * sn[e]; y2[e] = a1 * sn[e] + a2 * cs[e]; }
              u32x2 o1, o2; o1.x = cvt_pk_bf16(y1[0], y1[1]); o1.y = cvt_pk_bf16(y1[2], y1[3]); o2.x = cvt_pk_bf16(y2[0], y2[1]); o2.y = cvt_pk_bf16(y2[2], y2[3]);
              *(u32x2*)kp_ = o1; *(u32x2*)(kp_ + 64) = o2; }
            if (isx && lane < 32) { krp[lane] = f2bf(kr1 * kcs - kr2 * ksn); krp[lane + 32] = f2bf(kr1 * ksn + kr2 * kcs); }
        }
    }
    SEAM(11);

    if (IN(12)) {
        { pg8::Gemm g{Z + OC_CQ, W_QB, ODIN_P, 1024, 1024, 30, 0}; pg8::OrderX<> S{QMW / 256, G, bx}; pg8::EpiBf16 E{QM, QMW, 1 << 30};
          pg8::gemm_phase(L, g, S, E, wave); }
        { pg8::Gemm g{Z + OC_CKV, W_KVB, ODIN_P, 512, 512, 30, 0}; pg8::OrderAll S{KVW / 256, G, bx}; pg8::EpiBf16 E{KVM, KVW, 1 << 30};
          pg8::gemm_phase(L, g, S, E, wave); }
    }
    SEAM(12);


    if (IN(14)) {
        const int xg = bx & 7, kk = bx >> 3;
        const int nper = G >> 3;
        for (int i = 0; ; ++i) {
            const int un = (i * 8 + xg) * nper + kk; if (un >= 1024) break;
            const int bh = un >> 3, qb = un & 7, b = bh >> 4, h = bh & 15;
            const size_t krow0 = (size_t)b * LT, qrow0 = krow0 + CTXL + (size_t)qb * 256;
            att::attn_body<192, MLA_SDEPTH, QMW, KVW, ODIN_P, KVW, D>(QM + qrow0 * QMW + h * 192, KVM + krow0 * KVW + h * 256, Z + krow0 * ODIN_P + OC_KR, KVM + krow0 * KVW + h * 256 + 128,
                                                           YC + qrow0 * D + h * 128, LT, 0.07216878364870322f, (char*)lds, wave, ROPEM + (size_t)qb * 256 * 32, ROPEM + 2048 * 32 + (size_t)qb * 256 * 32);
        }
        for (int i = 0; ; ++i) {
            const int un = (i * 8 + xg) * nper + kk; if (un >= 1024) break;
            const int grp = un >> 5, r = un & 31, b = grp >> 2, kvh = grp & 3, h = kvh * 4 + (r >> 3), qb = r & 7;
            const size_t krow0 = (size_t)b * LT, qrow0 = krow0 + CTXL + (size_t)qb * 256;
            att::attn_body<128, GQA_SDEPTH, ODIN_P, ODIN_P, ODIN_P, ODIN_P, D>(Z + qrow0 * ODIN_P + OC_GQ + h * 128, Z + krow0 * ODIN_P + OC_GK + kvh * 128, nullptr, Z + krow0 * ODIN_P + OC_GV + kvh * 128,
                                                                   YC + qrow0 * D + 2048 + h * 128, LT, 0.08838834764831845f, (char*)lds, wave);
        }
    }
    SEAM(14);

    if (IN(15)) {
        pg8::Gemm g{YC, W_ODOUT, D, D, D, 30, 0}; pg8::OrderX<8> S{D / 256, G, bx}; pg8::EpiResGate E{X, nullptr, nullptr, MOD + (size_t)9 * MODW + 2 * D, false, XB, nullptr};
        pg8::gemm_phase(L, g, S, E, wave);
    }
    SEAM(15);

    if (IN(16)) { const int tid = launder_tid(wave), lane = tid & 63; (void)tid; (void)lane; conv_catchup(cc, CV_OPT_HI, NH_P7 * 8, (const int*)(ctl + CW_HSTOP), gw, NGW, wave, L); __syncthreads(); norm_coop_x(XB, H, args.in[I_N2G] + D, MOD + (size_t)9 * MODW + 3 * D, vcu, G, wave, (LAS float*)L); }
    SEAM(16);

    if (IN(17)) {
        if (bx < G - NH_P17) { pg8::Gemm g{H, (const bf16_t*)(ws + WS_WGU + WGU_L), D, D, D, 30, 0}; pg8::OrderX<> S{FFN2 / 256, G - NH_P17, bx}; pg8::EpiSwiGLU E{HID, FFH};
            pg8::gemm_phase(L, g, S, E, wave); }
        else conv_range(cc, CV_P17_LO, CV_P17_HI, bx - (G - NH_P17), NH_P17, wave, L);
    }
    SEAM(17);

    if (IN(18)) {
        pg8::Gemm g{HID, (const bf16_t*)(ws + WS_WDOWN + WDOWN_L), FFH, FFH, FFH, 30, 0}; pg8::OrderX<8> S{D / 256, G, bx}; pg8::EpiResGate E{X, nullptr, nullptr, MOD + (size_t)9 * MODW + 5 * D, false, XB, nullptr};
        pg8::gemm_phase(L, g, S, E, wave);
    }
    SEAM(18);

    if (IN(19)) { const int tid = launder_tid(wave), lane = tid & 63; (void)tid; (void)lane;
        const float* gvec = args.in[I_FING];
        for (int idx = gw; idx < NB * SEQ; idx += NGW) {
            const bf16_t* srow = XB + (size_t)xrow(idx) * D; float* orow = args.out + (size_t)idx * D;
            u32x4 v[8]; float ss = 0.f;
#pragma unroll
            for (int q = 0; q < 8; ++q) { v[q] = *(const u32x4*)(srow + (q * 64 + lane) * 8);
                const float a0 = bf_lo(v[q].x), a1 = bf_hi(v[q].x), a2 = bf_lo(v[q].y), a3 = bf_hi(v[q].y), a4 = bf_lo(v[q].z), a5 = bf_hi(v[q].z), a6 = bf_lo(v[q].w), a7 = bf_hi(v[q].w);
                ss += ((a0 * a0 + a1 * a1) + (a2 * a2 + a3 * a3)) + ((a4 * a4 + a5 * a5) + (a6 * a6 + a7 * a7)); }
            const float rstd = 1.0f / sqrtf(wave_sum(ss) * (1.0f / D) + EPS);
#pragma unroll
            for (int q = 0; q < 8; ++q) { const int c = (q * 64 + lane) * 8;
                const f32x4 x0 = (f32x4){bf_lo(v[q].x), bf_hi(v[q].x), bf_lo(v[q].y), bf_hi(v[q].y)}, x1 = (f32x4){bf_lo(v[q].z), bf_hi(v[q].z), bf_lo(v[q].w), bf_hi(v[q].w)};
                *(f32x4*)(orow + c) = x0 * rstd * *(const f32x4*)(gvec + c); *(f32x4*)(orow + c + 4) = x1 * rstd * *(const f32x4*)(gvec + c + 4); }
        }
    }
#undef IN
#undef SEAM
}

extern "C" void kernel_launch(void* const* d_in, const int* in_sizes, int n_in, void* d_out, int out_size, void* d_ws, size_t ws_size, hipStream_t stream) {
    static int grid = 0;
    if (grid == 0) {
        if (n_in != 26 || out_size != NB * SEQ * D || ws_size < WS_END) { fprintf(stderr, "kernel_launch: unexpected shapes: n_in %d out %d ws %zu (need %zu); nothing launched\n", n_in, out_size, ws_size, (size_t)WS_END); grid = -1; return; }
        int dev = 0, cus = 0;
        if (hipGetDevice(&dev) != hipSuccess || hipDeviceGetAttribute(&cus, hipDeviceAttributeMultiprocessorCount, dev) != hipSuccess) { grid = -1; return; }
        if (hipFuncSetAttribute((const void*)trunk_fwd, hipFuncAttributeMaxDynamicSharedMemorySize, LDS_BYTES) != hipSuccess) { fprintf(stderr, "kernel_launch: hipFuncSetAttribute failed\n"); grid = -1; return; }
        int per_cu = 0;
        if (hipOccupancyMaxActiveBlocksPerMultiprocessor(&per_cu, (const void*)trunk_fwd, 512, LDS_BYTES) != hipSuccess || per_cu < 1) fprintf(stderr, "kernel_launch: occupancy query says %d\n", per_cu);
        (void)hipGetLastError();
        grid = cus;
    }
    if (grid < 0) return;
    (void)hipMemsetAsync((char*)d_ws + WS_CTL, 0, CTL_BYTES, stream);
    Args a{};
    for (int i = 0; i < 26; ++i) a.in[i] = (const float*)d_in[i];
    a.out = (float*)d_out; a.ws = (unsigned char*)d_ws;
#if MK_N_LAUNCHES == 1
    a.ph_lo = 0; a.ph_hi = N_PHASES;
    hipLaunchKernelGGL(trunk_fwd, dim3(grid), dim3(512), LDS_BYTES, stream, a);
#else
    for (int p = 0; p < N_PHASES; ++p) { a.ph_lo = p; a.ph_hi = p + 1; hipLaunchKernelGGL(trunk_fwd, dim3(grid), dim3(512), LDS_BYTES, stream, a); }
#endif
    const hipError_t le = hipPeekAtLastError();
    if (le != hipSuccess) fprintf(stderr, "kernel_launch: launch failed: %s\n", hipGetErrorName(le));
}
```

```cpp
#include <hip/hip_runtime.h>
#include <cstdio>
#include <cstdint>

#ifndef MK_N_LAUNCHES
#define MK_N_LAUNCHES 1
#endif

#define LAS __attribute__((address_space(3)))
#define GAS __attribute__((address_space(1)))
typedef unsigned short bf16_t;
typedef short bf16x8 __attribute__((ext_vector_type(8)));
typedef short s16x4 __attribute__((ext_vector_type(4)));
typedef float f32x2 __attribute__((ext_vector_type(2)));
typedef float f32x4 __attribute__((ext_vector_type(4)));
typedef float f32x16 __attribute__((ext_vector_type(16)));
typedef unsigned u32x2 __attribute__((ext_vector_type(2)));
typedef unsigned u32x4 __attribute__((ext_vector_type(4)));

constexpr int D = 4096, NB = 8, SEQ = 2048, CTXL = 256, LT = SEQ + CTXL  , MALL = NB * LT  ;
constexpr int NPAN = MALL / 256  , NPANX = NB * SEQ / 256  ;
constexpr int MODW = 6 * D;
constexpr int FFH = 11008, FFN2 = 2 * FFH;
constexpr int EV_IN = 6144;
constexpr int ODIN = 4672, ODIN_P = 4864;
constexpr int OC_CQ = 0, OC_GQ = 1024, OC_CKV = 3072, OC_GK = 3584, OC_GV = 4096, OC_KR = 4608;
constexpr int QMW = 3072, KVW = 4096;
constexpr float EPS = 1e-6f;

constexpr size_t MiB = 1u << 20;
constexpr size_t al(size_t x) { return (x + MiB - 1) / MiB * MiB; }
constexpr size_t WS_CTL = 0, CTL_BYTES = 1 * MiB;
constexpr size_t WS_MOD = WS_CTL + CTL_BYTES;
constexpr size_t WS_ROPEM = WS_MOD + al((size_t)2 * 9 * MODW * 4);
constexpr size_t WS_ROPEG = WS_ROPEM + al((size_t)2 * 2048 * 32 * 4);
constexpr size_t WS_WEVIN = WS_ROPEG + al((size_t)2 * 2048 * 64 * 4);
constexpr size_t WS_WEVOUT = WS_WEVIN + al((size_t)EV_IN * D * 2);
constexpr size_t WS_WPOOL = WS_WEVOUT + al((size_t)D * D * 2);
constexpr size_t WS_WSGU = WS_WPOOL + al((size_t)4 * 512 * 512 * 2);
constexpr size_t WS_WGU = WS_WSGU + al((size_t)4 * 128 * 128 * 2);
constexpr size_t WGU_L = (size_t)FFN2 * D * 2;
constexpr size_t WS_WDOWN = WS_WGU + al(2 * WGU_L);
constexpr size_t WDOWN_L = (size_t)D * FFH * 2;
constexpr size_t WS_WODIN = WS_WDOWN + al(2 * WDOWN_L);
constexpr size_t WS_WQB = WS_WODIN + al((size_t)ODIN_P * D * 2);
constexpr size_t WS_WKVB = WS_WQB + al((size_t)QMW * 1024 * 2);
constexpr size_t WS_WODOUT = WS_WKVB + al((size_t)KVW * 512 * 2);
constexpr size_t WS_X = WS_WODOUT + al((size_t)D * D * 2);
constexpr size_t WS_H = WS_X + al((size_t)MALL * D * 4);
constexpr size_t WS_Z = WS_H + al((size_t)MALL * D * 2);
constexpr size_t WS_PA = WS_Z + al((size_t)MALL * EV_IN * 2);
constexpr size_t WS_YC = WS_PA + al((size_t)MALL * 2048 * 2);
constexpr size_t WS_HID = WS_YC + al((size_t)MALL * D * 2);
constexpr size_t WS_QM = WS_HID + al((size_t)MALL * FFH * 2);
constexpr size_t WS_KVM = WS_QM + al((size_t)MALL * QMW * 2);
constexpr size_t WS_XB = WS_KVM + al((size_t)MALL * KVW * 2);
constexpr size_t WS_PART = WS_XB + al((size_t)MALL * D * 2);
constexpr size_t WS_END = WS_PART + al((size_t)2 * NB * CTXL * D * 4);
constexpr int CW_BAR = 4096, CW_HDONE = 80000, CW_HSTOP = 80064;

constexpr int RING_BYTES = 131072, MISC_OFF = RING_BYTES + 320, LDS_BYTES = 147456;

__device__ __forceinline__ unsigned cvt_pk_bf16(float lo, float hi) { unsigned r; asm volatile("v_cvt_pk_bf16_f32 %0, %1, %2" : "=v"(r) : "v"(lo), "v"(hi)); return r; }
__device__ __forceinline__ float bf_lo(unsigned w) { return __uint_as_float(w << 16); }
__device__ __forceinline__ float bf_hi(unsigned w) { return __uint_as_float(w & 0xffff0000u); }
__device__ __forceinline__ float bf2f(bf16_t b) { return __uint_as_float(((unsigned)b) << 16); }
__device__ __forceinline__ bf16_t f2bf(float f) { return (bf16_t)(cvt_pk_bf16(f, 0.f) & 0xffffu); }
__device__ __forceinline__ float wave_sum(float v) {
#pragma unroll
    for (int o = 1; o < 64; o <<= 1) v += __shfl_xor(v, o);
    return v;
}
__device__ __forceinline__ int lane_id() { return (int)__builtin_amdgcn_mbcnt_hi(~0u, __builtin_amdgcn_mbcnt_lo(~0u, 0u)); }
__device__ __forceinline__ int launder_tid(int wave) { int t = wave * 64 + lane_id(); asm volatile("" : "+v"(t)); return t; }
#define LDS_WAIT() asm volatile("s_waitcnt lgkmcnt(0)" ::: "memory")
#define VM_WAIT() asm volatile("s_waitcnt vmcnt(0)" ::: "memory")
__device__ __forceinline__ int xrow(int idx) { return (idx >> 11) * LT + CTXL + (idx & 2047); }
__device__ __forceinline__ int pan_x(int pmx) { return (pmx >> 3) * 9 + 1 + (pmx & 7); }
__device__ __forceinline__ int mod_row_of_panel(int pm) { return (pm % 9 == 0) ? 8 : pm / 9; }

namespace pg8 {
constexpr int BM = 256, BK = 64, HALF = 128, HTB = HALF * BK * 2, STAGE_BYTES = 8 * HTB, NXCD = 8, WGM = 8;
__host__ __device__ __forceinline__ int lds_byte(int r, int c) { const int st = (r >> 4) * 2 + (c >> 5), rr = r & 15, cc = c & 31, ob = rr * 64 + cc * 2; return st * 1024 + (ob ^ (((ob >> 9) & 1) << 5)); }
__host__ __device__ __forceinline__ void stage_rc(int b, int& R, int& C) { const int st = b / 1024, sb = b % 1024, swz = sb ^ (((sb >> 9) & 1) << 5); R = (st >> 1) * 16 + swz / 64; C = (st & 1) * 32 + (swz % 64) / 2; }
__host__ __device__ __forceinline__ int perm32(int rho) { const int n = rho >> 4, i = rho & 15; return 8 * (i >> 2) + 4 * n + (i & 3); }

struct Unit { int pm, pn, k0t, split; };
struct Gemm { const bf16_t* A; const bf16_t* Bt; int lda, ldb, K, ashift, astride; };

template <int WGM_>
__device__ __forceinline__ void grid_unit(int wgid, int nM, int nN, int& pm, int& pn) {
    const int nwg = nM * nN;
    { const int q = nwg / NXCD, r = nwg % NXCD, xcd = wgid % NXCD, off = wgid / NXCD; wgid = (xcd < r ? xcd * (q + 1) : r * (q + 1) + (xcd - r) * q) + off; }
    const int nig = WGM_ * nN, gid = wgid / nig, fm = gid * WGM_, gsz = (nM - fm) < WGM_ ? (nM - fm) : WGM_;
    pm = fm + ((wgid % nig) % gsz); pn = (wgid % nig) / gsz;
}
struct OrderAll {
    int nN, G, c;
    __device__ __forceinline__ bool next(int i, Unit& u) const { const long L = (long)i * G + c; if (c >= G || L >= (long)NPAN * nN) return false; grid_unit<9>((int)L, NPAN, nN, u.pm, u.pn); u.k0t = 0; u.split = 0; return true; }
};
template <int WG_PAN = 8>
struct OrderX {
    int nN, G, c;
    __device__ __forceinline__ bool next(int i, Unit& u) const { const long L = (long)i * G + c; if (c >= G || L >= (long)NPANX * nN) return false; int pm; grid_unit<WG_PAN>((int)L, NPANX, nN, pm, u.pn); u.pm = pan_x(pm); u.k0t = 0; u.split = 0; return true; }
};
template <int WG_PAN = 8>
struct OrderXSplitCtx {
    int G, c, ntk;
    __device__ __forceinline__ bool next(int i, Unit& u) const { const int L = i * G + c;
        if (L < NPANX * 16) { int pm; grid_unit<WG_PAN>(L, NPANX, 16, pm, u.pn); u.pm = pan_x(pm); u.k0t = 0; u.split = 0; return true; }
        const int l2 = L - NPANX * 16; if (l2 >= 256) return false; const int tile = l2 >> 1; u.pm = (tile >> 4) * 9; u.pn = tile & 15; u.k0t = (l2 & 1) * (ntk >> 1); u.split = 1 + (l2 & 1); return true; }
};
struct OrderOdIn {
    int G, c;
    __device__ __forceinline__ bool next(int i, Unit& u) const { const int L = i * G + c; constexpr int NXU = NPANX * 19; u.k0t = 0; u.split = 0;
        if (L < NXU) { int pm; grid_unit<8>(L, NPANX, 19, pm, u.pn); u.pm = pan_x(pm); return true; }
        const int l2 = L - NXU; if (l2 >= 8 * 7) return false; u.pm = (l2 & 7) * 9; u.pn = 12 + (l2 >> 3); return true; }
};

template <class Epi, class Sched>
__device__ __forceinline__ void gemm_phase(LAS unsigned char* lds, const Gemm g, const Sched& S, const Epi& E, const int wave) {
    const int tid = launder_tid(wave), wid = wave, lane = tid & 63, wr = wid >> 2, wc = wid & 3, fr = lane & 15, fq = lane >> 4;
    const int K = g.K, nt = K / BK;
    unsigned voffA[2], voffB[2];
#pragma unroll
    for (int i = 0; i < 2; ++i) { int R, C; stage_rc(tid * 16 + i * 8192, R, C); const int Rb = Epi::PERM ? ((R & ~31) + perm32(R & 31)) : R;
        voffA[i] = (unsigned)(R * g.lda + C) * 2u; voffB[i] = (unsigned)(Rb * g.ldb + C) * 2u; }
    const size_t kstep = (size_t)(BK * 2);
    const size_t hstepA = (size_t)HALF * g.lda * 2, hstepB = (size_t)HALF * g.ldb * 2;
    const unsigned ldsw = (unsigned)wid * 1024u;
    const int aoff = lds_byte(wr * 64 + fr, fq * 8), boff = lds_byte(wc * 32 + fr, fq * 8);
#define PG8_SA(b, h) (((b) * 2 + (h)) * HTB)
#define PG8_SB(b, h) ((4 + (b) * 2 + (h)) * HTB)
#define PG8_STAGE(bufoff, gbase, voff) do { _Pragma("unroll") for (int _i = 0; _i < 2; ++_i) \
        __builtin_amdgcn_global_load_lds((const unsigned*)((const char*)(gbase) + (voff)[_i]), (LAS unsigned*)(lds + (bufoff) + ldsw + _i * 8192), 16, 0, 0); } while (0)
#define PG8_LDA(dst, b, h) do { _Pragma("unroll") for (int m = 0; m < 4; ++m) _Pragma("unroll") for (int k = 0; k < 2; ++k) dst[m][k] = *(const LAS bf16x8*)(lds + PG8_SA(b, h) + aoff + m * 2048 + k * 1024); } while (0)
#define PG8_LDB(dst, b, h) do { _Pragma("unroll") for (int n = 0; n < 2; ++n) _Pragma("unroll") for (int k = 0; k < 2; ++k) dst[n][k] = *(const LAS bf16x8*)(lds + PG8_SB(b, h) + boff + n * 2048 + k * 1024); } while (0)
#define PG8_MMA(ai, bj, At, Bt) do { __builtin_amdgcn_s_setprio(1); _Pragma("unroll") for (int m = 0; m < 4; ++m) _Pragma("unroll") for (int n = 0; n < 2; ++n) _Pragma("unroll") for (int k = 0; k < 2; ++k) \
        acc[ai][bj][m][n] = __builtin_amdgcn_mfma_f32_16x16x32_bf16(Bt[n][k], At[m][k], acc[ai][bj][m][n], 0, 0, 0); __builtin_amdgcn_s_setprio(0); } while (0)
#define PG8_WAIT_V(n) asm volatile("s_waitcnt vmcnt(" #n ")" ::: "memory")
#define PG8_WAIT_L(n) asm volatile("s_waitcnt lgkmcnt(" #n ")" ::: "memory")
#define PG8_BAR __builtin_amdgcn_s_barrier()
#define PG8_SCHED __builtin_amdgcn_sched_barrier(0)
    Unit cur, nxt; int ui = 0;
    if (!S.next(0, cur)) return;
    f32x4 acc[2][2][4][2];
#pragma unroll
    for (int a = 0; a < 2; ++a)
#pragma unroll
        for (int b = 0; b < 2; ++b)
#pragma unroll
            for (int m = 0; m < 4; ++m)
#pragma unroll
                for (int n = 0; n < 2; ++n) acc[a][b][m][n] = (f32x4){0.f, 0.f, 0.f, 0.f};
    bf16x8 At[4][2], B0[2][2], B1[2][2];
    const char* cA = (const char*)g.A + (size_t)cur.pm * 2 * hstepA + (size_t)(cur.pn >> g.ashift) * g.astride * 2 + (size_t)cur.k0t * kstep;
    const char* cB = (const char*)g.Bt + (size_t)cur.pn * 2 * hstepB + (size_t)cur.k0t * kstep;
    PG8_STAGE(PG8_SB(0, 0), cB, voffB); PG8_STAGE(PG8_SB(0, 1), cB + hstepB, voffB); PG8_STAGE(PG8_SA(0, 0), cA, voffA); PG8_STAGE(PG8_SA(0, 1), cA + hstepA, voffA);
    if (wr == 1) PG8_BAR;
    PG8_WAIT_V(2); PG8_BAR;
    PG8_STAGE(PG8_SB(1, 0), cB + kstep, voffB); PG8_STAGE(PG8_SA(1, 0), cA + kstep, voffA); PG8_STAGE(PG8_SB(1, 1), cB + hstepB + kstep, voffB);
    PG8_WAIT_V(6); PG8_BAR;
    for (;;) {
        const bool has_next = S.next(ui + 1, nxt);
        const char* nA = has_next ? (const char*)g.A + (size_t)nxt.pm * 2 * hstepA + (size_t)(nxt.pn >> g.ashift) * g.astride * 2 + (size_t)nxt.k0t * kstep : cA;
        const char* nB = has_next ? (const char*)g.Bt + (size_t)nxt.pn * 2 * hstepB + (size_t)nxt.k0t * kstep : cB;
        const int unt = cur.split ? (nt >> 1) : nt;
        for (int t = 0; t < unt; t += 2) {
            const bool last = (t == unt - 2);
            const char* a1 = cA + (size_t)(t + 1) * kstep;
            const char* a2 = last ? nA : cA + (size_t)(t + 2) * kstep; const char* b2 = last ? nB : cB + (size_t)(t + 2) * kstep;
            const char* a3 = a2 + kstep; const char* b3 = b2 + kstep;
            PG8_LDB(B0, 0, 0); PG8_LDB(B1, 0, 1); PG8_SCHED; PG8_LDA(At, 0, 0); PG8_STAGE(PG8_SA(1, 1), a1 + hstepA, voffA);
            PG8_WAIT_V(8); PG8_WAIT_L(0); PG8_BAR; PG8_MMA(0, 0, At, B0); PG8_MMA(0, 1, At, B1); PG8_BAR; PG8_SCHED;
            PG8_LDA(At, 0, 1); PG8_STAGE(PG8_SB(0, 0), b2, voffB); PG8_STAGE(PG8_SB(0, 1), b2 + hstepB, voffB); PG8_STAGE(PG8_SA(0, 0), a2, voffA);
            PG8_WAIT_V(8); PG8_WAIT_L(0); PG8_BAR; PG8_MMA(1, 0, At, B0); PG8_MMA(1, 1, At, B1); PG8_BAR; PG8_SCHED;
            PG8_LDB(B0, 1, 0); PG8_LDB(B1, 1, 1); PG8_SCHED; PG8_LDA(At, 1, 0); PG8_STAGE(PG8_SA(0, 1), a2 + hstepA, voffA);
            PG8_WAIT_V(8); PG8_WAIT_L(0); PG8_BAR; PG8_MMA(0, 0, At, B0); PG8_MMA(0, 1, At, B1); PG8_BAR; PG8_SCHED;
            PG8_LDA(At, 1, 1); PG8_STAGE(PG8_SB(1, 0), b3, voffB); PG8_STAGE(PG8_SB(1, 1), b3 + hstepB, voffB); PG8_STAGE(PG8_SA(1, 0), a3, voffA);
            PG8_WAIT_V(8); PG8_WAIT_L(0); PG8_BAR; PG8_MMA(1, 0, At, B0); PG8_MMA(1, 1, At, B1); PG8_BAR; PG8_SCHED;
        }
        if (wr == 0) PG8_BAR;
        E(acc, cur, wr, wc, fr, fq);
        if (!has_next) break;
#pragma unroll
        for (int a = 0; a < 2; ++a)
#pragma unroll
            for (int b = 0; b < 2; ++b)
#pragma unroll
                for (int m = 0; m < 4; ++m)
#pragma unroll
                    for (int n = 0; n < 2; ++n) acc[a][b][m][n] = (f32x4){0.f, 0.f, 0.f, 0.f};
        cur = nxt; cA = nA; cB = nB; ++ui;
        if (wr == 1) PG8_BAR;
    }
    PG8_WAIT_V(0);
    PG8_BAR;
#undef PG8_SA
#undef PG8_SB
#undef PG8_STAGE
#undef PG8_LDA
#undef PG8_LDB
#undef PG8_MMA
#undef PG8_WAIT_V
#undef PG8_WAIT_L
#undef PG8_BAR
#undef PG8_SCHED
}

__device__ __forceinline__ f32x2 gelu_tanh_pk(f32x2 x) {
    const f32x2 x2 = x * x, p = x2 * 0.044715f + 1.0f, t = (x * p) * (-2.3022081986f);
    f32x2 e; e.x = __builtin_amdgcn_exp2f(t.x); e.y = __builtin_amdgcn_exp2f(t.y);
    const f32x2 d = e + 1.0f;
    f32x2 r; r.x = __builtin_amdgcn_rcpf(d.x); r.y = __builtin_amdgcn_rcpf(d.y);
    return x * r;
}
struct EpiBf16 {
    static constexpr bool PERM = true;
    bf16_t* O; int ldc; int act_from;
    __device__ __forceinline__ void operator()(const f32x4 (&acc)[2][2][4][2], const Unit& u, int wr, int wc, int fr, int fq) const {
        const int row0 = u.pm * BM + wr * 64 + fr, col0 = u.pn * BM + wc * 32 + 8 * fq; const bool act = u.pn >= act_from;
#pragma unroll
        for (int ai = 0; ai < 2; ++ai)
#pragma unroll
            for (int m = 0; m < 4; ++m) { bf16_t* rowp = O + (size_t)(row0 + ai * HALF + m * 16) * ldc + col0;
#pragma unroll
                for (int bj = 0; bj < 2; ++bj) { f32x4 v0 = acc[ai][bj][m][0], v1 = acc[ai][bj][m][1];
                    if (act) { const f32x2 a = gelu_tanh_pk((f32x2){v0[0], v0[1]}), b = gelu_tanh_pk((f32x2){v0[2], v0[3]}), c = gelu_tanh_pk((f32x2){v1[0], v1[1]}), d = gelu_tanh_pk((f32x2){v1[2], v1[3]});
                        v0 = (f32x4){a.x, a.y, b.x, b.y}; v1 = (f32x4){c.x, c.y, d.x, d.y}; }
                    u32x4 w; w.x = cvt_pk_bf16(v0[0], v0[1]); w.y = cvt_pk_bf16(v0[2], v0[3]); w.z = cvt_pk_bf16(v1[0], v1[1]); w.w = cvt_pk_bf16(v1[2], v1[3]);
                    *(u32x4*)(rowp + bj * HALF) = w; } }
    }
};
struct EpiPool {
    static constexpr bool PERM = true;
    bf16_t* O; int ldc; const float* scale;
    __device__ __forceinline__ void operator()(const f32x4 (&acc)[2][2][4][2], const Unit& u, int wr, int wc, int fr, int fq) const {
        const int row0 = u.pm * BM + wr * 64 + fr, col0 = u.pn * BM + wc * 32 + 8 * fq;
        f32x4 sv[2][2];
#pragma unroll
        for (int bj = 0; bj < 2; ++bj)
#pragma unroll
            for (int n = 0; n < 2; ++n) sv[bj][n] = *(const f32x4*)(scale + col0 + bj * HALF + 4 * n);
#pragma unroll
        for (int ai = 0; ai < 2; ++ai)
#pragma unroll
            for (int m = 0; m < 4; ++m) { bf16_t* rowp = O + (size_t)(row0 + ai * HALF + m * 16) * ldc + col0;
#pragma unroll
                for (int bj = 0; bj < 2; ++bj) { const f32x4 v0 = acc[ai][bj][m][0] * sv[bj][0], v1 = acc[ai][bj][m][1] * sv[bj][1];
                    u32x4 w; w.x = cvt_pk_bf16(v0[0], v0[1]); w.y = cvt_pk_bf16(v0[2], v0[3]); w.z = cvt_pk_bf16(v1[0], v1[1]); w.w = cvt_pk_bf16(v1[2], v1[3]);
                    *(u32x4*)(rowp + bj * HALF) = w; } }
    }
};
__device__ __forceinline__ f32x2 swiglu_pk(f32x2 g, f32x2 u) {
    const f32x2 t = g * (-1.4426950408889634f);
    f32x2 e; e.x = __builtin_amdgcn_exp2f(t.x); e.y = __builtin_amdgcn_exp2f(t.y);
    const f32x2 d = e + 1.0f;
    f32x2 r; r.x = __builtin_amdgcn_rcpf(d.x); r.y = __builtin_amdgcn_rcpf(d.y);
    return (g * u) * r;
}
struct EpiSwiGLU {
    static constexpr bool PERM = true;
    bf16_t* O; int ldc;
    __device__ __forceinline__ void operator()(const f32x4 (&acc)[2][2][4][2], const Unit& u, int wr, int wc, int fr, int fq) const {
        const int row0 = u.pm * BM + wr * 64 + fr, col0 = u.pn * HALF + wc * 32 + 8 * fq;
#pragma unroll
        for (int ai = 0; ai < 2; ++ai)
#pragma unroll
            for (int m = 0; m < 4; ++m) { bf16_t* rowp = O + (size_t)(row0 + ai * HALF + m * 16) * ldc + col0;
                const f32x4 g0 = acc[ai][0][m][0], g1 = acc[ai][0][m][1], u0 = acc[ai][1][m][0], u1 = acc[ai][1][m][1];
                const f32x2 h0 = swiglu_pk((f32x2){g0[0], g0[1]}, (f32x2){u0[0], u0[1]}), h1 = swiglu_pk((f32x2){g0[2], g0[3]}, (f32x2){u0[2], u0[3]});
                const f32x2 h2 = swiglu_pk((f32x2){g1[0], g1[1]}, (f32x2){u1[0], u1[1]}), h3 = swiglu_pk((f32x2){g1[2], g1[3]}, (f32x2){u1[2], u1[3]});
                u32x4 w; w.x = cvt_pk_bf16(h0.x, h0.y); w.y = cvt_pk_bf16(h1.x, h1.y); w.z = cvt_pk_bf16(h2.x, h2.y); w.w = cvt_pk_bf16(h3.x, h3.y);
                *(u32x4*)rowp = w; }
    }
};
struct EpiResGate {
    static constexpr bool PERM = true;
    float* X; const float* xin; const float* ctxin; const float* gate; bool from_input; bf16_t* XB; float* PART;
    __device__ __forceinline__ void operator()(const f32x4 (&acc)[2][2][4][2], const Unit& u, int wr, int wc, int fr, int fq) const {
        const int lrow0 = wr * 64 + fr, col0 = u.pn * BM + wc * 32 + 8 * fq;
        const int b = u.pm / 9, p = u.pm % 9;
        if (u.split) {
            float* po = PART + ((size_t)(u.split - 1) * NB * CTXL + (size_t)b * CTXL) * D + col0;
#pragma unroll
            for (int ai = 0; ai < 2; ++ai)
#pragma unroll
                for (int m = 0; m < 4; ++m) { const size_t ro = (size_t)(lrow0 + ai * HALF + m * 16) * D;
#pragma unroll
                    for (int bj = 0; bj < 2; ++bj) { *(f32x4*)(po + ro + bj * HALF) = acc[ai][bj][m][0]; *(f32x4*)(po + ro + bj * HALF + 4) = acc[ai][bj][m][1]; } }
            return;
        }
        const float* gp = gate + (size_t)(p == 0 ? 8 : b) * MODW + col0;
        const float* bs = from_input ? (p == 0 ? ctxin + (size_t)b * CTXL * D : xin + ((size_t)b * SEQ + (size_t)(p - 1) * 256) * D) + col0 : nullptr;
        bf16_t* xb = XB + (size_t)u.pm * BM * D + col0;
        f32x4 gv[2][2];
#pragma unroll
        for (int bj = 0; bj < 2; ++bj)
#pragma unroll
            for (int n = 0; n < 2; ++n) gv[bj][n] = *(const f32x4*)(gp + bj * HALF + n * 4);
#pragma unroll
        for (int q = 0; q < 4; ++q) {
            const int ai = q >> 1, m0 = (q & 1) * 2;
            f32x4 bv[2][2][2];
            if (from_input) {
#pragma unroll
                for (int mm = 0; mm < 2; ++mm) { const size_t ro = (size_t)(lrow0 + ai * HALF + (m0 + mm) * 16) * D;
#pragma unroll
                    for (int bj = 0; bj < 2; ++bj) { bv[mm][bj][0] = *(const f32x4*)(bs + ro + bj * HALF); bv[mm][bj][1] = *(const f32x4*)(bs + ro + bj * HALF + 4); } }
            } else {
                u32x4 bw[2][2];
#pragma unroll
                for (int mm = 0; mm < 2; ++mm) { const size_t ro = (size_t)(lrow0 + ai * HALF + (m0 + mm) * 16) * D;
#pragma unroll
                    for (int bj = 0; bj < 2; ++bj) bw[mm][bj] = *(const u32x4*)(xb + ro + bj * HALF); }
#pragma unroll
                for (int mm = 0; mm < 2; ++mm)
#pragma unroll
                    for (int bj = 0; bj < 2; ++bj) { const u32x4 w = bw[mm][bj];
                        bv[mm][bj][0] = (f32x4){bf_lo(w.x), bf_hi(w.x), bf_lo(w.y), bf_hi(w.y)}; bv[mm][bj][1] = (f32x4){bf_lo(w.z), bf_hi(w.z), bf_lo(w.w), bf_hi(w.w)}; }
            }
            asm volatile("" ::: "memory");
#pragma unroll
            for (int mm = 0; mm < 2; ++mm) { const int m = m0 + mm; const size_t ro = (size_t)(lrow0 + ai * HALF + m * 16) * D;
#pragma unroll
                for (int bj = 0; bj < 2; ++bj) {
                    const f32x4 o0 = bv[mm][bj][0] + gv[bj][0] * acc[ai][bj][m][0], o1 = bv[mm][bj][1] + gv[bj][1] * acc[ai][bj][m][1];
                    u32x4 w; w.x = cvt_pk_bf16(o0[0], o0[1]); w.y = cvt_pk_bf16(o0[2], o0[3]); w.z = cvt_pk_bf16(o1[0], o1[1]); w.w = cvt_pk_bf16(o1[2], o1[3]); *(u32x4*)(xb + ro + bj * HALF) = w; } }
            asm volatile("" ::: "memory");
        }
    }
};
}

namespace att {
constexpr int NW = 8, QBLK = 32, KVBLK = 64;
constexpr int SHM_V = KVBLK * 128 * 2, SHM_K = KVBLK * 128 * 2, SHM_K2 = KVBLK * 64 * 2;
constexpr int OFF_V = 0, OFF_K = 2 * SHM_V, OFF_K2 = OFF_K + 2 * SHM_K, OFF_WS = OFF_K2 + 2 * SHM_K2, OFF_QR = OFF_WS + NW * 64 * 4, ATT_LDS = OFF_QR + NW * 4096;
#define KSWZ(row, colB) ((row) * 256 + ((colB) ^ (((row) & 7) << 4)))
#define KSWZ2(row, colB) ((row) * 128 + ((colB) ^ ((((row) >> 1) & 7) << 4)))
#define SBAR() __builtin_amdgcn_sched_barrier(0)
__device__ __forceinline__ int crow(int r, int hi) { return (r & 3) + 8 * (r >> 2) + 4 * hi; }
__device__ __forceinline__ void partialSM(f32x16& p0, f32x16& p1, float& m_reg, float& mn, float& alpha, const float C, const float thr_s) {
  float pmax = p0[0];
#pragma unroll
  for (int r = 1; r < 16; ++r) pmax = fmaxf(pmax, p0[r]);
#pragma unroll
  for (int r = 0; r < 16; ++r) pmax = fmaxf(pmax, p1[r]);
  { auto rr = __builtin_amdgcn_permlane32_swap(__float_as_uint(pmax), __float_as_uint(pmax), false, false);
    pmax = fmaxf(__uint_as_float(rr[0]), __uint_as_float(rr[1])); }
  if (__builtin_expect(__all(pmax - m_reg <= thr_s), 1)) { mn = m_reg; alpha = 1.f; }
  else { mn = fmaxf(m_reg, pmax); alpha = __builtin_amdgcn_exp2f((m_reg - mn) * C); m_reg = mn; }
  const float mnC = -mn * C;
#pragma unroll
  for (int r = 0; r < 16; ++r) p0[r] = fmaf(p0[r], C, mnC);
#pragma unroll
  for (int r = 0; r < 16; ++r) p1[r] = fmaf(p1[r], C, mnC);
#pragma unroll
  for (int r = 0; r < 16; ++r) p0[r] = __builtin_amdgcn_exp2f(p0[r]);
}
__device__ __forceinline__ void finishSM(f32x16& p0, f32x16& p1, float alpha, float& l_reg, bf16x8& pa0, bf16x8& pa1, bf16x8& pa2, bf16x8& pa3) {
#pragma unroll
  for (int r = 0; r < 16; ++r) p1[r] = __builtin_amdgcn_exp2f(p1[r]);
  float ps = 0;
#pragma unroll
  for (int r = 0; r < 16; ++r) ps += p0[r];
#pragma unroll
  for (int r = 0; r < 16; ++r) ps += p1[r];
  { auto rr = __builtin_amdgcn_permlane32_swap(__float_as_uint(ps), __float_as_uint(ps), false, false);
    ps = __uint_as_float(rr[0]) + __uint_as_float(rr[1]); }
  l_reg = l_reg * alpha + ps;
#define PK4(P, BASE, OUT) do { unsigned a0 = cvt_pk_bf16(P[BASE + 0], P[BASE + 1]), a1 = cvt_pk_bf16(P[BASE + 2], P[BASE + 3]);   \
    unsigned b0 = cvt_pk_bf16(P[BASE + 4], P[BASE + 5]), b1 = cvt_pk_bf16(P[BASE + 6], P[BASE + 7]);                              \
    auto r0 = __builtin_amdgcn_permlane32_swap(a0, b0, false, false); auto r1 = __builtin_amdgcn_permlane32_swap(a1, b1, false, false); \
    u32x4 w = {r0[0], r1[0], r0[1], r1[1]}; OUT = *reinterpret_cast<bf16x8*>(&w); } while (0)
  PK4(p0, 0, pa0); PK4(p0, 8, pa1); PK4(p1, 0, pa2); PK4(p1, 8, pa3);
#undef PK4
}
template <int DQK, bool QRL = false>
__device__ __forceinline__ void qkt(f32x16& p0, f32x16& p1, const char* Ks, const char* K2s, const bf16x8* qr, int r32, int hi, const char* qrl = nullptr) {
  p0 = f32x16{}; p1 = f32x16{};
#pragma unroll
  for (int d0 = 0; d0 < 8; ++d0) { const int cb = (d0 * 16 + hi * 8) * 2;
    const bf16x8 b0 = *reinterpret_cast<const bf16x8*>(Ks + KSWZ(r32, cb));
    const bf16x8 b1 = *reinterpret_cast<const bf16x8*>(Ks + KSWZ(32 + r32, cb));
    p0 = __builtin_amdgcn_mfma_f32_32x32x16_bf16(b0, qr[d0], p0, 0, 0, 0);
    p1 = __builtin_amdgcn_mfma_f32_32x32x16_bf16(b1, qr[d0], p1, 0, 0, 0); }
  if constexpr (DQK == 192) {
#pragma unroll
    for (int d0 = 0; d0 < 4; ++d0) { const int cb = (d0 * 16 + hi * 8) * 2;
      const bf16x8 b0 = *reinterpret_cast<const bf16x8*>(K2s + KSWZ2(r32, cb));
      const bf16x8 b1 = *reinterpret_cast<const bf16x8*>(K2s + KSWZ2(32 + r32, cb));
      bf16x8 q; if constexpr (QRL) q = *reinterpret_cast<const bf16x8*>(qrl + d0 * 1024); else q = qr[8 + d0];
      p0 = __builtin_amdgcn_mfma_f32_32x32x16_bf16(b0, q, p0, 0, 0, 0);
      p1 = __builtin_amdgcn_mfma_f32_32x32x16_bf16(b1, q, p1, 0, 0, 0); }
  }
}
__device__ __forceinline__ int v_st(int k, int c) { const int kk = (k & ~0xC) | ((k & 4) << 1) | ((k & 8) >> 1); return ((kk >> 3) * 4 + (c >> 5)) * 512 + ((kk & 7) * 32 + (c & 31)) * 2; }
__device__ __forceinline__ int v_rd_base(int lane) { return ((lane & 3) << 3) | (((lane >> 2) & 3) << 6) | (((lane >> 4) & 1) << 5) | (((lane >> 5) & 1) << 8); }
constexpr int v_rd_off(int d0, int ks, int half) { return d0 * 512 + ks * 4096 + half * 2048; }
template <int OFF> __device__ __forceinline__ s16x4 tr_read(int vb) {
  s16x4 r; asm volatile("ds_read_b64_tr_b16 %0, %1 offset:%2" : "=&v"(r) : "v"(vb), "i"(OFF) : "memory"); return r;
}
template <int D0> __device__ __forceinline__ void pv_one(f32x16& od, int vb, bf16x8 pa0, bf16x8 pa1, bf16x8 pa2, bf16x8 pa3) {
  const s16x4 l0 = tr_read<v_rd_off(D0, 0, 0)>(vb), h0 = tr_read<v_rd_off(D0, 0, 1)>(vb), l1 = tr_read<v_rd_off(D0, 1, 0)>(vb), h1 = tr_read<v_rd_off(D0, 1, 1)>(vb);
  const s16x4 l2 = tr_read<v_rd_off(D0, 2, 0)>(vb), h2 = tr_read<v_rd_off(D0, 2, 1)>(vb), l3 = tr_read<v_rd_off(D0, 3, 0)>(vb), h3 = tr_read<v_rd_off(D0, 3, 1)>(vb);
  asm volatile("s_waitcnt lgkmcnt(0)" ::: "memory"); SBAR();
#define PK(L, H) (bf16x8){L[0], L[1], L[2], L[3], H[0], H[1], H[2], H[3]}
  od = __builtin_amdgcn_mfma_f32_32x32x16_bf16(pa0, PK(l0, h0), od, 0, 0, 0);
  od = __builtin_amdgcn_mfma_f32_32x32x16_bf16(pa1, PK(l1, h1), od, 0, 0, 0);
  od = __builtin_amdgcn_mfma_f32_32x32x16_bf16(pa2, PK(l2, h2), od, 0, 0, 0);
  od = __builtin_amdgcn_mfma_f32_32x32x16_bf16(pa3, PK(l3, h3), od, 0, 0, 0);
#undef PK
}
__device__ __forceinline__ void pv_d0(f32x16* o, int vb, bf16x8 pa0, bf16x8 pa1, bf16x8 pa2, bf16x8 pa3) {
  pv_one<0>(o[0], vb, pa0, pa1, pa2, pa3); pv_one<1>(o[1], vb, pa0, pa1, pa2, pa3); pv_one<2>(o[2], vb, pa0, pa1, pa2, pa3); pv_one<3>(o[3], vb, pa0, pa1, pa2, pa3);
}
template <int D0> __device__ __forceinline__ void pvT_one(f32x16& od, int vb, bf16x8 pa0, bf16x8 pa1, bf16x8 pa2, bf16x8 pa3) {
  const s16x4 l0 = tr_read<v_rd_off(D0, 0, 0)>(vb), h0 = tr_read<v_rd_off(D0, 0, 1)>(vb), l1 = tr_read<v_rd_off(D0, 1, 0)>(vb), h1 = tr_read<v_rd_off(D0, 1, 1)>(vb);
  const s16x4 l2 = tr_read<v_rd_off(D0, 2, 0)>(vb), h2 = tr_read<v_rd_off(D0, 2, 1)>(vb), l3 = tr_read<v_rd_off(D0, 3, 0)>(vb), h3 = tr_read<v_rd_off(D0, 3, 1)>(vb);
  asm volatile("s_waitcnt lgkmcnt(0)" ::: "memory"); SBAR();
#define PK(L, H) (bf16x8){L[0], L[1], L[2], L[3], H[0], H[1], H[2], H[3]}
  od = __builtin_amdgcn_mfma_f32_32x32x16_bf16(PK(l0, h0), pa0, od, 0, 0, 0);
  od = __builtin_amdgcn_mfma_f32_32x32x16_bf16(PK(l1, h1), pa1, od, 0, 0, 0);
  od = __builtin_amdgcn_mfma_f32_32x32x16_bf16(PK(l2, h2), pa2, od, 0, 0, 0);
  od = __builtin_amdgcn_mfma_f32_32x32x16_bf16(PK(l3, h3), pa3, od, 0, 0, 0);
#undef PK
}
__device__ __forceinline__ void pvT_d0(f32x16* o, int vb, bf16x8 pa0, bf16x8 pa1, bf16x8 pa2, bf16x8 pa3) {
  pvT_one<0>(o[0], vb, pa0, pa1, pa2, pa3); pvT_one<1>(o[1], vb, pa0, pa1, pa2, pa3); pvT_one<2>(o[2], vb, pa0, pa1, pa2, pa3); pvT_one<3>(o[3], vb, pa0, pa1, pa2, pa3);
}
template <int DQK, int SDEPTH, int LDQ, int LDK, int LDK2, int LDV, int LDO>
__device__ __forceinline__ void attn_body(const bf16_t* __restrict__ Qb, const bf16_t* __restrict__ Kh, const bf16_t* __restrict__ K2h, const bf16_t* __restrict__ Vh,
                                          bf16_t* __restrict__ Ob, int seq, const float scale, char* lds, const int wave, const float* __restrict__ ropec = nullptr, const float* __restrict__ ropes = nullptr) {
  const float C = scale * 1.4426950408889634f, thr_s = 8.f / scale;
  const int tid = launder_tid(wave), wid = wave, lane = tid & 63, r32 = lane & 31, hi = lane >> 5;
  char* V_lds = lds + OFF_V; char* K_lds = lds + OFF_K; char* K2_lds = lds + OFF_K2;
  const char* qrl = lds + OFF_QR + wid * 4096 + lane * 16;
  float m_reg = -1e30f, l_reg = 0; f32x16 o[4] = {}; bf16x8 qr[8];
  const bf16_t* Qw = Qb + (long)(wid * QBLK + r32) * LDQ + hi * 8;
#pragma unroll
  for (int d0 = 0; d0 < 8; ++d0) qr[d0] = *reinterpret_cast<const bf16x8*>(Qw + d0 * 16);
  if constexpr (DQK == 192) {
    const float* cp = ropec + (wid * QBLK + r32) * 32 + 8 * hi; const float* sp = ropes + (wid * QBLK + r32) * 32 + 8 * hi;
#pragma unroll
    for (int e = 0; e < 2; ++e) {
      const f32x4 c0 = *(const f32x4*)(cp + 16 * e), c1 = *(const f32x4*)(cp + 16 * e + 4), s0 = *(const f32x4*)(sp + 16 * e), s1 = *(const f32x4*)(sp + 16 * e + 4);
      const u32x4 a = *reinterpret_cast<const u32x4*>(Qw + (8 + e) * 16), b = *reinterpret_cast<const u32x4*>(Qw + (10 + e) * 16);
      const float x1[8] = {bf_lo(a.x), bf_hi(a.x), bf_lo(a.y), bf_hi(a.y), bf_lo(a.z), bf_hi(a.z), bf_lo(a.w), bf_hi(a.w)};
      const float x2[8] = {bf_lo(b.x), bf_hi(b.x), bf_lo(b.y), bf_hi(b.y), bf_lo(b.z), bf_hi(b.z), bf_lo(b.w), bf_hi(b.w)};
      const float cc[8] = {c0.x, c0.y, c0.z, c0.w, c1.x, c1.y, c1.z, c1.w}, sn[8] = {s0.x, s0.y, s0.z, s0.w, s1.x, s1.y, s1.z, s1.w};
      float y1[8], y2[8];
#pragma unroll
      for (int j = 0; j < 8; ++j) { y1[j] = x1[j] * cc[j] - x2[j] * sn[j]; y2[j] = x1[j] * sn[j] + x2[j] * cc[j]; }
      u32x4 oa, ob; oa.x = cvt_pk_bf16(y1[0], y1[1]); oa.y = cvt_pk_bf16(y1[2], y1[3]); oa.z = cvt_pk_bf16(y1[4], y1[5]); oa.w = cvt_pk_bf16(y1[6], y1[7]);
      ob.x = cvt_pk_bf16(y2[0], y2[1]); ob.y = cvt_pk_bf16(y2[2], y2[3]); ob.z = cvt_pk_bf16(y2[4], y2[5]); ob.w = cvt_pk_bf16(y2[6], y2[7]);
      *(u32x4*)(const_cast<char*>(qrl) + e * 1024) = oa; *(u32x4*)(const_cast<char*>(qrl) + (2 + e) * 1024) = ob;
    }
    asm volatile("s_waitcnt lgkmcnt(0)" ::: "memory");
  }
  const int sr = tid >> 4, sc = (tid & 15) * 8, vst0 = v_st(sr, sc), vst1 = v_st(32 + sr, sc);
  const int s2r = tid >> 3, s2c = (tid & 7) * 8;
  const int vb0 = (int)(uintptr_t)V_lds + v_rd_base(lane);
  struct { bf16x8 vs0, vs1, ks0, ks1, k2; } sr_[SDEPTH];
#define SLOAD(i, k0) do { sr_[i].vs0 = *reinterpret_cast<const bf16x8*>(&Vh[(long)((k0) + sr) * LDV + sc]); sr_[i].vs1 = *reinterpret_cast<const bf16x8*>(&Vh[(long)((k0) + 32 + sr) * LDV + sc]); \
    sr_[i].ks0 = *reinterpret_cast<const bf16x8*>(&Kh[(long)((k0) + sr) * LDK + sc]); sr_[i].ks1 = *reinterpret_cast<const bf16x8*>(&Kh[(long)((k0) + 32 + sr) * LDK + sc]); \
    if constexpr (DQK == 192) sr_[i].k2 = *reinterpret_cast<const bf16x8*>(&K2h[(long)((k0) + s2r) * LDK2 + s2c]); } while (0)
#define SWRITE(b, i) do { *(bf16x8*)(V_lds + (b) * SHM_V + vst0) = sr_[i].vs0; *(bf16x8*)(V_lds + (b) * SHM_V + vst1) = sr_[i].vs1; const int kc = sc * 2; \
    *(bf16x8*)(K_lds + (b) * SHM_K + KSWZ(sr, kc)) = sr_[i].ks0; *(bf16x8*)(K_lds + (b) * SHM_K + KSWZ(32 + sr, kc)) = sr_[i].ks1; \
    if constexpr (DQK == 192) *(bf16x8*)(K2_lds + (b) * SHM_K2 + KSWZ2(s2r, s2c * 2)) = sr_[i].k2; } while (0)
#define SWAIT() do { if constexpr (SDEPTH == 1) asm volatile("s_waitcnt vmcnt(0)" ::: "memory"); else if constexpr (DQK == 192) asm volatile("s_waitcnt vmcnt(5)" ::: "memory"); else asm volatile("s_waitcnt vmcnt(4)" ::: "memory"); } while (0)
#define RESC(a) do { if (__any((a) < 1.f)) { _Pragma("unroll") for (int d = 0; d < 4; ++d) _Pragma("unroll") for (int r = 0; r < 16; ++r) o[d][r] *= (a); } } while (0)
  f32x16 pA0, pA1, pB0, pB1; float mnA, mnB, alA, alB; bf16x8 pa0, pa1, pa2, pa3; const int NT = seq / KVBLK;
  constexpr int SE = 0, SO = SDEPTH - 1;
  SLOAD(SE, 0); asm volatile("s_waitcnt vmcnt(0)" ::: "memory"); SWRITE(0, SE); __syncthreads();
  qkt<DQK, true>(pA0, pA1, K_lds, K2_lds, qr, r32, hi, qrl); partialSM(pA0, pA1, m_reg, mnA, alA, C, thr_s);
  SLOAD(SO, KVBLK); if constexpr (SDEPTH == 2) { if (2 < NT) SLOAD(SE, 2 * KVBLK); }
  SWAIT(); SWRITE(1, SO); __syncthreads();
  for (int j = 1; j + 1 < NT; j += 2) {
    SBAR(); qkt<DQK, true>(pB0, pB1, K_lds + SHM_K, K2_lds + SHM_K2, qr, r32, hi, qrl);
    finishSM(pA0, pA1, alA, l_reg, pa0, pa1, pa2, pa3); SBAR();
    SLOAD(SO, (j + SDEPTH) * KVBLK); SBAR();
    pvT_d0(o, vb0, pa0, pa1, pa2, pa3); partialSM(pB0, pB1, m_reg, mnB, alB, C, thr_s);
    __syncthreads(); SWAIT(); SWRITE(0, SE);
    RESC(alB); __syncthreads();
    SBAR(); qkt<DQK, true>(pA0, pA1, K_lds, K2_lds, qr, r32, hi, qrl);
    finishSM(pB0, pB1, alB, l_reg, pa0, pa1, pa2, pa3); SBAR();
    if (SDEPTH == 1 || j + 3 < NT) SLOAD(SE, (j + 1 + SDEPTH) * KVBLK); SBAR();
    pvT_d0(o, vb0 + SHM_V, pa0, pa1, pa2, pa3); partialSM(pA0, pA1, m_reg, mnA, alA, C, thr_s);
    __syncthreads(); SWAIT(); SWRITE(1, SO);
    RESC(alA); __syncthreads();
  }
  SBAR(); qkt<DQK, true>(pB0, pB1, K_lds + SHM_K, K2_lds + SHM_K2, qr, r32, hi, qrl);
  finishSM(pA0, pA1, alA, l_reg, pa0, pa1, pa2, pa3); SBAR();
  pvT_d0(o, vb0, pa0, pa1, pa2, pa3); partialSM(pB0, pB1, m_reg, mnB, alB, C, thr_s);
  __syncthreads(); RESC(alB);
  finishSM(pB0, pB1, alB, l_reg, pa0, pa1, pa2, pa3); SBAR();
  pvT_d0(o, vb0 + SHM_V, pa0, pa1, pa2, pa3);
  { const float rl = __builtin_amdgcn_rcpf(l_reg);
    bf16_t* Ow = Ob + (long)(wid * QBLK + r32) * LDO + 4 * hi;
#pragma unroll
    for (int d0 = 0; d0 < 4; ++d0)
#pragma unroll
      for (int g = 0; g < 4; ++g) { u32x2 w; w.x = cvt_pk_bf16(o[d0][4 * g + 0] * rl, o[d0][4 * g + 1] * rl); w.y = cvt_pk_bf16(o[d0][4 * g + 2] * rl, o[d0][4 * g + 3] * rl);
        *(u32x2*)(Ow + d0 * 32 + 8 * g) = w; } }
  __syncthreads();
#undef SLOAD
#undef SWRITE
#undef SWAIT
#undef RESC
}

}

#define XB_TMO      128
#define XB_XCNT(j)  (256  + 64 * (j))
#define XB_XSUB(j)  (1280 + 64 * (j))
#define XB_XGEN(j)  (2304 + 64 * (j))
#define XB_TOP      3328
#define XB_TOPGEN   3392
#define XCD_BAR_WORDS 3456
#define XB_SPIN_CAP (1u << 18)
__device__ __forceinline__ unsigned xb_ld(unsigned* p)              { return __hip_atomic_load(p, __ATOMIC_RELAXED, __HIP_MEMORY_SCOPE_AGENT); }
__device__ __forceinline__ unsigned xb_add(unsigned* p, unsigned v) { return __hip_atomic_fetch_add(p, v, __ATOMIC_RELAXED, __HIP_MEMORY_SCOPE_AGENT); }
__device__ __forceinline__ unsigned xb_xcc_id() { return (unsigned)__builtin_amdgcn_s_getreg((3 << 11) | 20) & 0xFu; }
#define XB_SPIN(cond, bar) do { unsigned _sp = 0; while (cond) { __builtin_amdgcn_s_sleep(1); \
    if ((++_sp & 255u) == 0u) { if (xb_ld(&(bar)[XB_TMO])) break; if (_sp > XB_SPIN_CAP) { atomicAdd(&(bar)[XB_TMO], 1u); break; } } } } while (0)
struct XcdBarrier { unsigned* bar; unsigned x; volatile LAS unsigned* st; };
__device__ __forceinline__ XcdBarrier xcd_barrier_post(unsigned* bar, volatile LAS unsigned* st) {
    XcdBarrier b; b.bar = bar; b.x = xb_xcc_id(); b.st = st;
    if (threadIdx.x == 0) (void)xb_add(&bar[XB_XCNT(b.x)], 1u);
    return b;
}
__device__ __forceinline__ void xcd_barrier_complete(unsigned* bar, unsigned x, unsigned& nloc, unsigned& nx) {
    const unsigned G = gridDim.x * gridDim.y * gridDim.z;
    unsigned sum, cnt, mine, sp = 0u;
    for (;;) {
        sum = 0u; cnt = 0u; mine = 0u;
#pragma unroll
        for (unsigned j = 0; j < 16; ++j) { const unsigned c = xb_ld(&bar[XB_XCNT(j)]); sum += c; cnt += (c > 0u) ? 1u : 0u; mine = (j == x) ? c : mine; }
        if (sum == G) break;
        __builtin_amdgcn_s_sleep(1);
        if ((++sp & 255u) == 0u) { if (xb_ld(&bar[XB_TMO])) break; if (sp > XB_SPIN_CAP) { atomicAdd(&bar[XB_TMO], 1u); break; } }
    }
    nloc = mine > 0u ? mine : 1u; nx = cnt > 0u ? cnt : 1u;
}
__device__ __forceinline__ void xcd_barrier(const XcdBarrier& b) {
    asm volatile("s_waitcnt vmcnt(0)" ::: "memory");
    __syncthreads();
    if (threadIdx.x == 0) {
        unsigned* bar = b.bar;
        __builtin_amdgcn_s_waitcnt(0);
        unsigned nloc = b.st[0], nx = b.st[1];
        if (nloc == 0u) { xcd_barrier_complete(bar, b.x, nloc, nx); b.st[0] = nloc; b.st[1] = nx; }
        const unsigned old = xb_add(&bar[XB_XSUB(b.x)], 1u);
        const unsigned gen = old / nloc;
        if (old + 1u == (gen + 1u) * nloc) {
            __builtin_amdgcn_fence(__ATOMIC_RELEASE, "agent");
            asm volatile("s_waitcnt vmcnt(0)" ::: "memory");
            const unsigned og = xb_add(&bar[XB_TOP], 1u);
            const unsigned tg = og / nx;
            if (og + 1u == (tg + 1u) * nx) xb_add(&bar[XB_TOPGEN], 1u);
            else XB_SPIN(xb_ld(&bar[XB_TOPGEN]) == tg, bar);
            __builtin_amdgcn_fence(__ATOMIC_ACQUIRE, "agent");
            xb_add(&bar[XB_XGEN(b.x)], 1u);
            asm volatile("s_waitcnt vmcnt(0)" ::: "memory");
        } else {
            XB_SPIN(xb_ld(&bar[XB_XGEN(b.x)]) == gen, bar);
            __builtin_amdgcn_fence(__ATOMIC_ACQUIRE, "agent");
            asm volatile("s_waitcnt vmcnt(0)" ::: "memory");
        }
    }
    __syncthreads();
}

struct Args { const float* in[26]; float* out; unsigned char* ws; int ph_lo, ph_hi; };
enum { I_X = 0, I_C, I_CTX, I_CCTX, I_MODW, I_MODB, I_N1G, I_N2G, I_FING, I_WGU, I_WDOWN, I_EVIN, I_POOLW, I_POOLS, I_SGUNG, I_SGUWS, I_SGUB, I_EVOUT,
       I_ODIN, I_QAG, I_WQB, I_KVAG, I_WKVB, I_QNG, I_KNG, I_ODOUT };
constexpr int N_PHASES = 20;
constexpr int GQA_SDEPTH = 1, MLA_SDEPTH = 1;
constexpr int NH_P2 = 8, NH_P7 = 8, NH_P17 = 0;

__device__ __forceinline__ void conv_item(const float* __restrict__ W, int K, int N, bf16_t* __restrict__ WT, int map, int it, LAS unsigned char* tile, int lane) {
    const int nnb = N / 64;
    const int kq = lane >> 4, nq = lane & 15, rn = lane >> 3, ch = lane & 7;
    const int kc = it / nnb, nb = it - kc * nnb, n0 = nb * 64;
    int dr = n0;
    if (map == 1) { const int isu = n0 >= FFH, j = isu ? n0 - FFH : n0; dr = 256 * (j >> 7) + (isu ? 128 : 0) + (j & 127); }
    else if (map == 2) { dr = n0 < 3584 ? n0 : (n0 < 3648 ? OC_KR + (n0 - 3584) : n0 - 64); }
    const float* src = W + (size_t)(kc * 64 + 16 * kq) * N + n0 + 4 * nq;
    f32x4 v[16];
#pragma unroll
    for (int i = 0; i < 16; ++i) v[i] = __builtin_nontemporal_load((const f32x4*)(src + (size_t)i * N));
#pragma unroll
    for (int j = 0; j < 4; ++j) {
        u32x4 c0, c1;
        c0.x = cvt_pk_bf16(v[0][j], v[1][j]); c0.y = cvt_pk_bf16(v[2][j], v[3][j]); c0.z = cvt_pk_bf16(v[4][j], v[5][j]); c0.w = cvt_pk_bf16(v[6][j], v[7][j]);
        c1.x = cvt_pk_bf16(v[8][j], v[9][j]); c1.y = cvt_pk_bf16(v[10][j], v[11][j]); c1.z = cvt_pk_bf16(v[12][j], v[13][j]); c1.w = cvt_pk_bf16(v[14][j], v[15][j]);
        const int n = 4 * nq + j, sw = nq & 7;
        *(LAS u32x4*)(tile + n * 128 + (((2 * kq) ^ sw) << 4)) = c0; *(LAS u32x4*)(tile + n * 128 + (((2 * kq + 1) ^ sw) << 4)) = c1;
    }
    LDS_WAIT(); asm volatile("" ::: "memory");
    bf16_t* dst = WT + (size_t)dr * K + kc * 64 + 8 * ch;
#pragma unroll
    for (int t = 0; t < 8; ++t) { const int n = rn + 8 * t; const u32x4 o = *(const LAS u32x4*)(tile + n * 128 + ((ch ^ ((n >> 2) & 7)) << 4)); *(u32x4*)(dst + (size_t)n * K) = o; }
    LDS_WAIT(); asm volatile("" ::: "memory");
}
constexpr int CI_POOL = 0, CI_EVOUT = CI_POOL + 4 * 64, CI_GU0 = CI_EVOUT + 4096, CI_DOWN0 = CI_GU0 + 22016, CI_ODIN = CI_DOWN0 + 11008, CI_QB = CI_ODIN + 4672, CI_KVB = CI_QB + 768,
              CI_ODOUT = CI_KVB + 512, CI_GU1 = CI_ODOUT + 4096, CI_DOWN1 = CI_GU1 + 22016, CI_END = CI_DOWN1 + 11008;
constexpr int CV_P0A_LO = 0,        CV_P0A_HI = CI_DOWN0;
constexpr int CV_P2_LO = CI_DOWN0,  CV_P2_HI = CI_DOWN0 + 5500;
constexpr int CV_P7_LO = CV_P2_HI,  CV_P7_HI = CI_DOWN0 + 26500;
constexpr int CV_P0B_LO = CI_END,  CV_P0B_HI = CI_END;
constexpr int CV_OPT_LO = CV_P7_HI, CV_OPT_HI = CI_END;
constexpr int CV_P17_LO = CI_END, CV_P17_HI = CI_END;
struct ConvCtx { const float* pool; const float* evout; const float* gu; const float* down; const float* odin; const float* qb; const float* kvb; const float* odout; unsigned char* ws; };
__device__ __forceinline__ void conv_list_item(const ConvCtx& c, int it, LAS unsigned char* tile, int lane) {
    if (it < CI_EVOUT) { const int g = it >> 6; conv_item(c.pool + (size_t)g * 512 * 512, 512, 512, (bf16_t*)(c.ws + WS_WPOOL) + (size_t)g * 512 * 512, 0, it & 63, tile, lane); }
    else if (it < CI_GU0) conv_item(c.evout, D, D, (bf16_t*)(c.ws + WS_WEVOUT), 0, it - CI_EVOUT, tile, lane);
    else if (it < CI_DOWN0) conv_item(c.gu, D, FFN2, (bf16_t*)(c.ws + WS_WGU), 1, it - CI_GU0, tile, lane);
    else if (it < CI_ODIN) conv_item(c.down, FFH, D, (bf16_t*)(c.ws + WS_WDOWN), 0, it - CI_DOWN0, tile, lane);
    else if (it < CI_QB) conv_item(c.odin, D, ODIN, (bf16_t*)(c.ws + WS_WODIN), 2, it - CI_ODIN, tile, lane);
    else if (it < CI_KVB) conv_item(c.qb, 1024, QMW, (bf16_t*)(c.ws + WS_WQB), 0, it - CI_QB, tile, lane);
    else if (it < CI_ODOUT) conv_item(c.kvb, 512, KVW, (bf16_t*)(c.ws + WS_WKVB), 0, it - CI_KVB, tile, lane);
    else if (it < CI_GU1) conv_item(c.odout, D, D, (bf16_t*)(c.ws + WS_WODOUT), 0, it - CI_ODOUT, tile, lane);
    else if (it < CI_DOWN1) conv_item(c.gu + (size_t)D * FFN2, D, FFN2, (bf16_t*)(c.ws + WS_WGU + WGU_L), 1, it - CI_GU1, tile, lane);
    else conv_item(c.down + (size_t)FFH * D, FFH, D, (bf16_t*)(c.ws + WS_WDOWN + WDOWN_L), 0, it - CI_DOWN1, tile, lane);
}
__device__ __forceinline__ void conv_desc(const ConvCtx& c, int it, int lane, const float*& src, int& N, bf16_t*& dst, int& K) {
    const float* W; bf16_t* WT; int map = 0, li;
    if (it < CI_EVOUT) { const int g = it >> 6; W = c.pool + (size_t)g * 512 * 512; K = 512; N = 512; WT = (bf16_t*)(c.ws + WS_WPOOL) + (size_t)g * 512 * 512; li = it & 63; }
    else if (it < CI_GU0) { W = c.evout; K = D; N = D; WT = (bf16_t*)(c.ws + WS_WEVOUT); li = it - CI_EVOUT; }
    else if (it < CI_DOWN0) { W = c.gu; K = D; N = FFN2; WT = (bf16_t*)(c.ws + WS_WGU); map = 1; li = it - CI_GU0; }
    else if (it < CI_ODIN) { W = c.down; K = FFH; N = D; WT = (bf16_t*)(c.ws + WS_WDOWN); li = it - CI_DOWN0; }
    else if (it < CI_QB) { W = c.odin; K = D; N = ODIN; WT = (bf16_t*)(c.ws + WS_WODIN); map = 2; li = it - CI_ODIN; }
    else if (it < CI_KVB) { W = c.qb; K = 1024; N = QMW; WT = (bf16_t*)(c.ws + WS_WQB); li = it - CI_QB; }
    else if (it < CI_ODOUT) { W = c.kvb; K = 512; N = KVW; WT = (bf16_t*)(c.ws + WS_WKVB); li = it - CI_KVB; }
    else if (it < CI_GU1) { W = c.odout; K = D; N = D; WT = (bf16_t*)(c.ws + WS_WODOUT); li = it - CI_ODOUT; }
    else if (it < CI_DOWN1) { W = c.gu + (size_t)D * FFN2; K = D; N = FFN2; WT = (bf16_t*)(c.ws + WS_WGU + WGU_L); map = 1; li = it - CI_GU1; }
    else { W = c.down + (size_t)FFH * D; K = FFH; N = D; WT = (bf16_t*)(c.ws + WS_WDOWN + WDOWN_L); li = it - CI_DOWN1; }
    const int nnb = N / 64, kq = lane >> 4, nq = lane & 15, ch = lane & 7;
    const int kc = li / nnb, nb = li - kc * nnb, n0 = nb * 64;
    int dr = n0;
    if (map == 1) { const int isu = n0 >= FFH, j = isu ? n0 - FFH : n0; dr = 256 * (j >> 7) + (isu ? 128 : 0) + (j & 127); }
    else if (map == 2) { dr = n0 < 3584 ? n0 : (n0 < 3648 ? OC_KR + (n0 - 3584) : n0 - 64); }
    src = W + (size_t)(kc * 64 + 16 * kq) * N + n0 + 4 * nq;
    dst = WT + (size_t)dr * K + kc * 64 + 8 * ch;
}
template <bool ADAPT = false>
__device__ __forceinline__ void conv_range(const ConvCtx& c, int lo, int hi, int hw, int nh, int wave, LAS unsigned char* L, unsigned* done_cnt = nullptr, unsigned done_need = 0u, int* stop_slot = nullptr) {
    const int lane = launder_tid(wave) & 63; LAS unsigned char* tile = L + wave * 8192;
    const int kq = lane >> 4, nq = lane & 15, rn = lane >> 3, ch = lane & 7, sw = nq & 7, stride = nh * 8;
    int it = lo + hw * 8 + wave; if (it >= hi) { if (ADAPT && lane == 0) __hip_atomic_store(stop_slot, hi, __ATOMIC_RELAXED, __HIP_MEMORY_SCOPE_AGENT); return; }
    const float* src; bf16_t* dst; int N, K; f32x4 v[16];
    conv_desc(c, it, lane, src, N, dst, K);
#pragma unroll
    for (int i = 0; i < 16; ++i) v[i] = __builtin_nontemporal_load((const f32x4*)(src + (size_t)i * N));
    for (;;) {
        const int nx = it + stride; const bool more = nx < hi;
        unsigned dn = 0u; if (ADAPT) dn = __hip_atomic_load(done_cnt, __ATOMIC_RELAXED, __HIP_MEMORY_SCOPE_AGENT);
        const float* src2 = src; bf16_t* dst2 = dst; int N2 = N, K2 = K; f32x4 w[16];
        if (more) { conv_desc(c, nx, lane, src2, N2, dst2, K2);
#pragma unroll
            for (int i = 0; i < 16; ++i) w[i] = __builtin_nontemporal_load((const f32x4*)(src2 + (size_t)i * N2)); }
#pragma unroll
        for (int j = 0; j < 4; ++j) {
            u32x4 c0, c1;
            c0.x = cvt_pk_bf16(v[0][j], v[1][j]); c0.y = cvt_pk_bf16(v[2][j], v[3][j]); c0.z = cvt_pk_bf16(v[4][j], v[5][j]); c0.w = cvt_pk_bf16(v[6][j], v[7][j]);
            c1.x = cvt_pk_bf16(v[8][j], v[9][j]); c1.y = cvt_pk_bf16(v[10][j], v[11][j]); c1.z = cvt_pk_bf16(v[12][j], v[13][j]); c1.w = cvt_pk_bf16(v[14][j], v[15][j]);
            const int n = 4 * nq + j;
            *(LAS u32x4*)(tile + n * 128 + (((2 * kq) ^ sw) << 4)) = c0; *(LAS u32x4*)(tile + n * 128 + (((2 * kq + 1) ^ sw) << 4)) = c1;
        }
        LDS_WAIT(); asm volatile("" ::: "memory");
#pragma unroll
        for (int t = 0; t < 8; ++t) { const int n = rn + 8 * t; const u32x4 o = *(const LAS u32x4*)(tile + n * 128 + ((ch ^ ((n >> 2) & 7)) << 4)); *(u32x4*)(dst + (size_t)n * K) = o; }
        LDS_WAIT(); asm volatile("" ::: "memory");
        if (!more) { if (ADAPT && lane == 0) __hip_atomic_store(stop_slot, hi, __ATOMIC_RELAXED, __HIP_MEMORY_SCOPE_AGENT); break; }
        if (ADAPT && (unsigned)__builtin_amdgcn_readfirstlane((int)dn) >= done_need) { if (lane == 0) __hip_atomic_store(stop_slot, nx, __ATOMIC_RELAXED, __HIP_MEMORY_SCOPE_AGENT); break; }
#pragma unroll
        for (int i = 0; i < 16; ++i) v[i] = w[i];
        it = nx; src = src2; dst = dst2; N = N2; K = K2;
    }
}

__device__ __forceinline__ void conv_catchup(const ConvCtx& c, int hi, int nslots, const int* stop, int gw, int ngw, int wave, LAS unsigned char* L) {
    const int lane = launder_tid(wave) & 63; LAS unsigned char* tile = L + wave * 8192;
    const int k = gw % nslots, j = gw / nslots, nj = ngw / nslots;
    for (int it = __builtin_amdgcn_readfirstlane(__hip_atomic_load(stop + k, __ATOMIC_RELAXED, __HIP_MEMORY_SCOPE_AGENT)) + j * nslots; it < hi; it += nj * nslots) conv_list_item(c, it, tile, lane);
}

template <int W>
__device__ __forceinline__ void pool_run(const bf16_t* __restrict__ Z, bf16_t* __restrict__ PA, int seg0, int segl, int t0, int g, int lane) {
    constexpr int HW = W / 2, NR = 8 + W - 1;
    const bf16_t* zc = Z + (size_t)seg0 * EV_IN + g * 512 + lane * 8;
    u32x4 rb[NR];
#pragma unroll
    for (int i = 0; i < NR; ++i) { int rr = t0 - HW + i; rr = min(max(rr, 0), segl - 1); rb[i] = *(const u32x4*)(zc + (size_t)rr * EV_IN); }
#pragma unroll
    for (int o = 0; o < 8; ++o) { const int t = t0 + o;
        float s[8];
#pragma unroll
        for (int e = 0; e < 8; ++e) s[e] = 0.f;
#pragma unroll
        for (int k = 0; k < W; ++k) { const int rr = t - HW + k; const float wgt = (rr >= 0 && rr < segl) ? 1.f : 0.f; const u32x4 q = rb[o + k];
            s[0] = fmaf(wgt, bf_lo(q.x), s[0]); s[1] = fmaf(wgt, bf_hi(q.x), s[1]); s[2] = fmaf(wgt, bf_lo(q.y), s[2]); s[3] = fmaf(wgt, bf_hi(q.y), s[3]);
            s[4] = fmaf(wgt, bf_lo(q.z), s[4]); s[5] = fmaf(wgt, bf_hi(q.z), s[5]); s[6] = fmaf(wgt, bf_lo(q.w), s[6]); s[7] = fmaf(wgt, bf_hi(q.w), s[7]); }
        const int wlo = max(t - HW, 0), whi = min(t - HW + W, segl); const float inv = 1.0f / (float)(whi - wlo);
        const u32x4 q = rb[o + HW];
        u32x4 r; r.x = cvt_pk_bf16(s[0] * inv - bf_lo(q.x), s[1] * inv - bf_hi(q.x)); r.y = cvt_pk_bf16(s[2] * inv - bf_lo(q.y), s[3] * inv - bf_hi(q.y));
        r.z = cvt_pk_bf16(s[4] * inv - bf_lo(q.z), s[5] * inv - bf_hi(q.z)); r.w = cvt_pk_bf16(s[6] * inv - bf_lo(q.w), s[7] * inv - bf_hi(q.w));
        *(u32x4*)(PA + (size_t)(seg0 + t) * 2048 + g * 512 + lane * 8) = r; }
}

__device__ __forceinline__ void norm_coop_x(const bf16_t* __restrict__ XB, bf16_t* __restrict__ H, const float* __restrict__ gvec, const float* __restrict__ modl  ,
                                            int wg, int nwg, int wave, LAS float* red) {
    const int lane = launder_tid(wave) & 63, c = 512 * wave + 8 * lane;
    for (int chunk = wg; chunk < NB * SEQ / 64; chunk += nwg) {
        const int b = chunk >> 5;
        const float* shp = modl + (size_t)b * MODW + c; const float* scp = shp + D;
        float A[8], Bc[8];
        { const f32x4 g0 = *(const f32x4*)(gvec + c), g1 = *(const f32x4*)(gvec + c + 4), s10 = *(const f32x4*)scp, s11 = *(const f32x4*)(scp + 4), s00 = *(const f32x4*)shp, s01 = *(const f32x4*)(shp + 4);
#pragma unroll
          for (int e = 0; e < 4; ++e) { A[e] = g0[e] * (s10[e] + 1.0f); A[4 + e] = g1[e] * (s11[e] + 1.0f); Bc[e] = s00[e]; Bc[4 + e] = s01[e]; } }
        const size_t row0 = (size_t)xrow(chunk * 64);
#pragma unroll 1
        for (int g = 0; g < 4; ++g) {
            const bf16_t* src = XB + (row0 + g * 16) * D + c;
            u32x4 v[16]; float ps[16];
#pragma unroll
            for (int r = 0; r < 16; ++r) v[r] = *(const u32x4*)(src + (size_t)r * D);
#pragma unroll
            for (int r = 0; r < 16; ++r) { const float a0 = bf_lo(v[r].x), a1 = bf_hi(v[r].x), a2 = bf_lo(v[r].y), a3 = bf_hi(v[r].y), a4 = bf_lo(v[r].z), a5 = bf_hi(v[r].z), a6 = bf_lo(v[r].w), a7 = bf_hi(v[r].w);
                ps[r] = wave_sum((a0 * a0 + a1 * a1) + (a2 * a2 + a3 * a3) + (a4 * a4 + a5 * a5) + (a6 * a6 + a7 * a7)); }
            LAS float* rb = red + (g & 1) * 128;
            if (lane < 16) { float mine = ps[0];
#pragma unroll
                for (int r = 1; r < 16; ++r) mine = (lane == r) ? ps[r] : mine;
                rb[lane * 8 + wave] = mine; }
            LDS_WAIT(); __syncthreads();
            bf16_t* dst = H + (row0 + g * 16) * D + c;
#pragma unroll
            for (int r = 0; r < 16; ++r) { const f32x4 t0 = *(const LAS f32x4*)(rb + r * 8), t1 = *(const LAS f32x4*)(rb + r * 8 + 4);
                const float tot = ((t0[0] + t0[1]) + (t0[2] + t0[3])) + ((t1[0] + t1[1]) + (t1[2] + t1[3]));
                const float rstd = 1.0f / sqrtf(tot * (1.0f / D) + EPS);
                const float x0 = bf_lo(v[r].x), x1 = bf_hi(v[r].x), x2 = bf_lo(v[r].y), x3 = bf_hi(v[r].y), x4 = bf_lo(v[r].z), x5 = bf_hi(v[r].z), x6 = bf_lo(v[r].w), x7 = bf_hi(v[r].w);
                u32x4 w; w.x = cvt_pk_bf16(x0 * rstd * A[0] + Bc[0], x1 * rstd * A[1] + Bc[1]); w.y = cvt_pk_bf16(x2 * rstd * A[2] + Bc[2], x3 * rstd * A[3] + Bc[3]);
                w.z = cvt_pk_bf16(x4 * rstd * A[4] + Bc[4], x5 * rstd * A[5] + Bc[5]); w.w = cvt_pk_bf16(x6 * rstd * A[6] + Bc[6], x7 * rstd * A[7] + Bc[7]);
                *(u32x4*)(dst + (size_t)r * D) = w; }
        }
        __syncthreads();
    }
}

__global__ void __launch_bounds__(512, 2) trunk_fwd(Args args) {
    extern __shared__ __attribute__((aligned(16))) unsigned char lds[];
    LAS unsigned char* L = (LAS unsigned char*)lds;
    volatile LAS unsigned* MISC = (volatile LAS unsigned*)(L + MISC_OFF);
    const int wave = __builtin_amdgcn_readfirstlane((int)threadIdx.x >> 6);
    const int G = gridDim.x, bx = blockIdx.x, vcu = (G % 8 == 0) ? (bx % 8) * (G / 8) + bx / 8 : bx;
    const int gw = vcu * 8 + wave, NGW = G * 8;
    unsigned char* ws = args.ws;
    unsigned* ctl = (unsigned*)(ws + WS_CTL);
    float* MOD = (float*)(ws + WS_MOD);
    float* ROPEM = (float*)(ws + WS_ROPEM); float* ROPEG = (float*)(ws + WS_ROPEG);
    bf16_t* W_EVIN = (bf16_t*)(ws + WS_WEVIN); bf16_t* W_EVOUT = (bf16_t*)(ws + WS_WEVOUT); bf16_t* W_POOL = (bf16_t*)(ws + WS_WPOOL); bf16_t* W_SGU = (bf16_t*)(ws + WS_WSGU);
    bf16_t* W_ODIN = (bf16_t*)(ws + WS_WODIN); bf16_t* W_QB = (bf16_t*)(ws + WS_WQB); bf16_t* W_KVB = (bf16_t*)(ws + WS_WKVB); bf16_t* W_ODOUT = (bf16_t*)(ws + WS_WODOUT);
    float* X = (float*)(ws + WS_X); bf16_t* H = (bf16_t*)(ws + WS_H); bf16_t* Z = (bf16_t*)(ws + WS_Z); bf16_t* PA = (bf16_t*)(ws + WS_PA); bf16_t* YC = (bf16_t*)(ws + WS_YC);
    bf16_t* XB = (bf16_t*)(ws + WS_XB); float* PART = (float*)(ws + WS_PART); bf16_t* HID = (bf16_t*)(ws + WS_HID); bf16_t* QM = (bf16_t*)(ws + WS_QM); bf16_t* KVM = (bf16_t*)(ws + WS_KVM);

    const ConvCtx cc{args.in[I_POOLW], args.in[I_EVOUT], args.in[I_WGU], args.in[I_WDOWN], args.in[I_ODIN], args.in[I_WQB], args.in[I_WKVB], args.in[I_ODOUT], ws};
    for (int u = threadIdx.x; u < (LDS_BYTES - RING_BYTES) / 4; u += 512) ((LAS unsigned*)(L + RING_BYTES))[u] = 0u;
    __syncthreads();
#if MK_N_LAUNCHES == 1
    XcdBarrier bar = xcd_barrier_post(ctl + CW_BAR, MISC + 8);
#define GRID_BAR() xcd_barrier(bar)
#else
#define GRID_BAR() do {} while (0)
#endif
    const int lo = args.ph_lo, hi = args.ph_hi;
#define IN(k) (lo <= (k) && (k) < hi)
#define SEAM(k) do { if (IN(k) && IN((k) + 1)) GRID_BAR(); } while (0)

    if (IN(0)) { const int tid = launder_tid(wave), lane = tid & 63; (void)tid; (void)lane;
        for (int s01 = 0; s01 < 2; ++s01) {
        if ((s01 == 0) == (((bx >> 3) & 1) == 0)) {
            LAS float* red = (LAS float*)L;
            for (int item = vcu; item < 256; item += G) {
                const int layer = item >> 7, cb = item & 127, col0 = cb * 192 + 3 * lane;
                const float* Wl = args.in[I_MODW] + (size_t)layer * D * MODW;
                float acc[9][3];
#pragma unroll
                for (int r = 0; r < 9; ++r) { acc[r][0] = 0.f; acc[r][1] = 0.f; acc[r][2] = 0.f; }
                for (int ch = 0; ch < 8; ++ch) {
                    const int k0 = wave * 512 + ch * 64;
                    float sv[9];
#pragma unroll
                    for (int r = 0; r < 9; ++r) { const float cv = (r < 8) ? args.in[I_C][r * D + k0 + lane] : args.in[I_CCTX][k0 + lane]; sv[r] = cv / (1.0f + expf(-cv)); }
                    const float* wp = Wl + (size_t)k0 * MODW + col0;
#pragma unroll 16
                    for (int kk = 0; kk < 64; ++kk) {
                        const float w0 = __builtin_nontemporal_load(wp + (size_t)kk * MODW), w1 = __builtin_nontemporal_load(wp + (size_t)kk * MODW + 1), w2 = __builtin_nontemporal_load(wp + (size_t)kk * MODW + 2);
#pragma unroll
                        for (int r = 0; r < 9; ++r) { const float s = __builtin_bit_cast(float, __builtin_amdgcn_readlane(__builtin_bit_cast(int, sv[r]), kk)); acc[r][0] = fmaf(s, w0, acc[r][0]); acc[r][1] = fmaf(s, w1, acc[r][1]); acc[r][2] = fmaf(s, w2, acc[r][2]); }
                    }
                }
#pragma unroll
                for (int r = 0; r < 9; ++r)
#pragma unroll
                    for (int e = 0; e < 3; ++e) red[(wave * 27 + r * 3 + e) * 64 + lane] = acc[r][e];
                __syncthreads();
                for (int o = tid; o < 27 * 64; o += 512) {
                    float s = 0.f;
#pragma unroll
                    for (int w = 0; w < 8; ++w) s += red[w * 27 * 64 + o];
                    const int j = o >> 6, ln = o & 63, r = j / 3, e = j % 3, col = cb * 192 + 3 * ln + e;
                    MOD[((size_t)layer * 9 + r) * MODW + col] = s + args.in[I_MODB][layer * MODW + col];
                }
                __syncthreads();
            }
        } else {
          LAS unsigned char* tile = L + wave * 8192;
          for (int it = gw; it < (D / 64) * (EV_IN / 64); it += NGW) conv_item(args.in[I_EVIN], D, EV_IN, W_EVIN, 0, it, tile, lane);
          for (int it = CV_P0A_LO + gw; it < CV_P0A_HI; it += NGW) conv_list_item(cc, it, tile, lane);
          for (int it = CV_P0B_LO + gw; it < CV_P0B_HI; it += NGW) conv_list_item(cc, it, tile, lane);
          __syncthreads();
        } }
        for (int i = gw * 64 + lane; i < 2048 * 96; i += NGW * 64) {
            const int t = i / 96, f = i % 96; const float row = (float)(t >> 6), colp = (float)(t & 63);
            if (f < 32) { const int ff = f & 15; const float inv = powf(10000.0f, -(float)ff / 16.0f); const float ang = (f < 16 ? row : colp) * inv; ROPEM[t * 32 + f] = cosf(ang); ROPEM[2048 * 32 + t * 32 + f] = sinf(ang); }
            else { const int f2 = f - 32, ff = f2 & 31; const float inv = powf(10000.0f, -(float)ff / 32.0f); const float ang = (f2 < 32 ? row : colp) * inv; ROPEG[t * 64 + f2] = cosf(ang); ROPEG[2048 * 64 + t * 64 + f2] = sinf(ang); }
        }
        for (int i = gw * 64 + lane; i < 4 * 128 * 128; i += NGW * 64) W_SGU[i] = f2bf(args.in[I_SGUWS][i]);
        for (int i = gw * 64 + lane; i < (ODIN_P - ODIN) * D / 8; i += NGW * 64) *(u32x4*)(W_ODIN + (size_t)ODIN * D + (size_t)i * 8) = (u32x4){0u, 0u, 0u, 0u};
    }
    SEAM(0);

#define NORM_PHASE(LAYER, WHICH, FROM_INPUT, XONLY) do { \
        const float* gvec = args.in[(WHICH) == 0 ? I_N1G : I_N2G] + (LAYER) * D; \
        const int nrows = (XONLY) ? NB * SEQ : MALL; \
        for (int idx = gw; idx < nrows; idx += NGW) { \
            const int R = (XONLY) ? xrow(idx) : idx; const int b = R / LT, j = R % LT; const int mr = j < CTXL ? 8 : b; \
            const float* srow = (FROM_INPUT) ? (j < CTXL ? args.in[I_CTX] + ((size_t)b * CTXL + j) * D : args.in[I_X] + ((size_t)b * SEQ + (j - CTXL)) * D) : X + (size_t)R * D; \
            const float* shp = MOD + ((size_t)(LAYER) * 9 + mr) * MODW + (WHICH) * 3 * D; const float* scp = shp + D; \
            f32x4 v[16]; float ss = 0.f; \
            _Pragma("unroll") for (int q = 0; q < 16; ++q) { v[q] = *(const f32x4*)(srow + (q * 64 + lane) * 4); ss += (v[q].x * v[q].x + v[q].y * v[q].y) + (v[q].z * v[q].z + v[q].w * v[q].w); } \
            const float rstd = 1.0f / sqrtf(wave_sum(ss) * (1.0f / D) + EPS); \
            bf16_t* hrow = H + (size_t)R * D; \
            _Pragma("unroll") for (int q = 0; q < 16; ++q) { const int c = (q * 64 + lane) * 4; const f32x4 gg = *(const f32x4*)(gvec + c), s1 = *(const f32x4*)(scp + c), s0 = *(const f32x4*)(shp + c); \
                const f32x4 y = v[q] * rstd * gg * (s1 + 1.0f) + s0; u32x2 w; w.x = cvt_pk_bf16(y.x, y.y); w.y = cvt_pk_bf16(y.z, y.w); *(u32x2*)(hrow + c) = w; } \
        } } while (0)

#define NORM_PHASE_B(LAYER, WHICH, XONLY) do { \
        const float* gvec = args.in[(WHICH) == 0 ? I_N1G : I_N2G] + (LAYER) * D; \
        const int nrows = (XONLY) ? NB * SEQ : MALL; \
        for (int idx = gw; idx < nrows; idx += NGW) { \
            const int R = (XONLY) ? xrow(idx) : idx; const int b = R / LT, j = R % LT; const int mr = j < CTXL ? 8 : b; \
            const bf16_t* srow = XB + (size_t)R * D; \
            const float* shp = MOD + ((size_t)(LAYER) * 9 + mr) * MODW + (WHICH) * 3 * D; const float* scp = shp + D; \
            u32x4 v[8]; float ss = 0.f; \
            _Pragma("unroll") for (int q = 0; q < 8; ++q) { v[q] = *(const u32x4*)(srow + (q * 64 + lane) * 8); \
                const float a0 = bf_lo(v[q].x), a1 = bf_hi(v[q].x), a2 = bf_lo(v[q].y), a3 = bf_hi(v[q].y), a4 = bf_lo(v[q].z), a5 = bf_hi(v[q].z), a6 = bf_lo(v[q].w), a7 = bf_hi(v[q].w); \
                ss += (a0 * a0 + a1 * a1) + (a2 * a2 + a3 * a3) + (a4 * a4 + a5 * a5) + (a6 * a6 + a7 * a7); } \
            const float rstd = 1.0f / sqrtf(wave_sum(ss) * (1.0f / D) + EPS); \
            bf16_t* hrow = H + (size_t)R * D; \
            _Pragma("unroll") for (int q = 0; q < 8; ++q) { const int c = (q * 64 + lane) * 8; \
                const f32x4 g0 = *(const f32x4*)(gvec + c), g1 = *(const f32x4*)(gvec + c + 4), s10 = *(const f32x4*)(scp + c), s11 = *(const f32x4*)(scp + c + 4), s00 = *(const f32x4*)(shp + c), s01 = *(const f32x4*)(shp + c + 4); \
                const f32x4 x0 = (f32x4){bf_lo(v[q].x), bf_hi(v[q].x), bf_lo(v[q].y), bf_hi(v[q].y)}, x1 = (f32x4){bf_lo(v[q].z), bf_hi(v[q].z), bf_lo(v[q].w), bf_hi(v[q].w)}; \
                const f32x4 y0 = x0 * rstd * g0 * (s10 + 1.0f) + s00, y1 = x1 * rstd * g1 * (s11 + 1.0f) + s01; \
                u32x4 w; w.x = cvt_pk_bf16(y0.x, y0.y); w.y = cvt_pk_bf16(y0.z, y0.w); w.z = cvt_pk_bf16(y1.x, y1.y); w.w = cvt_pk_bf16(y1.z, y1.w); *(u32x4*)(hrow + c) = w; } \
        } } while (0)

#define NORM_CTX_COMBINE(LAYER, WHICH, FROM_INPUT, GATEP, STORE_X) do { \
        const float* gvec = args.in[(WHICH) == 0 ? I_N1G : I_N2G] + (LAYER) * D; \
        const float* shp = MOD + ((size_t)(LAYER) * 9 + 8) * MODW + (WHICH) * 3 * D; const float* scp = shp + D; \
        for (int cr = gw; cr < NB * CTXL; cr += NGW) { \
            const int b = cr >> 8, j = cr & 255; const size_t R = (size_t)b * LT + j; \
            const float* srow = (FROM_INPUT) ? args.in[I_CTX] + (size_t)cr * D : X + R * D; \
            const float* p0 = PART + (size_t)cr * D; const float* p1 = p0 + (size_t)NB * CTXL * D; \
            f32x4 v[16]; float ss = 0.f; \
            _Pragma("unroll") for (int q = 0; q < 16; ++q) { const int c = (q * 64 + lane) * 4; \
                v[q] = *(const f32x4*)(srow + c) + *(const f32x4*)((GATEP) + c) * (*(const f32x4*)(p0 + c) + *(const f32x4*)(p1 + c)); \
                if (STORE_X) *(f32x4*)(X + R * D + c) = v[q]; \
                ss += (v[q].x * v[q].x + v[q].y * v[q].y) + (v[q].z * v[q].z + v[q].w * v[q].w); \
                if ((q & 3) == 3) asm volatile("" ::: "memory"); } \
            const float rstd = 1.0f / sqrtf(wave_sum(ss) * (1.0f / D) + EPS); \
            bf16_t* hrow = H + R * D; \
            _Pragma("unroll") for (int q = 0; q < 16; ++q) { const int c = (q * 64 + lane) * 4; const f32x4 gg = *(const f32x4*)(gvec + c), s1 = *(const f32x4*)(scp + c), s0 = *(const f32x4*)(shp + c); \
                const f32x4 y = v[q] * rstd * gg * (s1 + 1.0f) + s0; u32x2 w; w.x = cvt_pk_bf16(y.x, y.y); w.y = cvt_pk_bf16(y.z, y.w); *(u32x2*)(hrow + c) = w; } \
        } } while (0)

    if (IN(1)) { const int tid = launder_tid(wave), lane = tid & 63; (void)tid; (void)lane; NORM_PHASE(0, 0, true, false); }
    SEAM(1);

    if (IN(2)) {
        if (bx < G - NH_P2) { pg8::Gemm g{H, W_EVIN, D, D, D, 30, 0}; pg8::OrderAll S{EV_IN / 256, G - NH_P2, bx}; pg8::EpiBf16 E{Z, EV_IN, 8};
            pg8::gemm_phase(L, g, S, E, wave); }
        else conv_range(cc, CV_P2_LO, CV_P2_HI, bx - (G - NH_P2), NH_P2, wave, L);
    }
    SEAM(2);

    if (IN(3)) { const int tid = launder_tid(wave), lane = tid & 63; (void)tid; (void)lane;
        {
            constexpr int nitems = (MALL / 8) * 4; const int nheavy = (G >= 128 ? 64 : 0) * 8, nlight = NGW - nheavy, rest = nitems - 2 * nheavy;
            const int it_lo = gw < nheavy ? 2 * gw : 2 * nheavy + (int)((long)(gw - nheavy) * rest / nlight), it_hi = gw < nheavy ? 2 * gw + 2 : 2 * nheavy + (int)((long)(gw - nheavy + 1) * rest / nlight);
            for (int it = it_lo; it < it_hi; ++it) {
                const int g = it & 3, R0 = (it >> 2) * 8;
                const int b = R0 / LT, j = R0 % LT; const int seg0 = j < CTXL ? b * LT : b * LT + CTXL, segl = j < CTXL ? CTXL : SEQ, t0 = R0 - seg0;
                if (g == 0) pool_run<2>(Z, PA, seg0, segl, t0, 0, lane); else if (g == 1) pool_run<4>(Z, PA, seg0, segl, t0, 1, lane);
                else if (g == 2) pool_run<8>(Z, PA, seg0, segl, t0, 2, lane); else pool_run<16>(Z, PA, seg0, segl, t0, 3, lane);
            }
        }
        {
            const int wp = wave & 3, wd = wave >> 2, r32 = lane & 31, hl = lane >> 5;
            for (int un = vcu; un < (MALL / 128) * 4; un += G) {
                const int ch = un >> 2, h = un & 3, R0 = ch * 128;
                bf16x8 pa[8];
                { const bf16_t* wsp = W_SGU + ((size_t)h * 128 + 32 * wp + r32) * 128 + 8 * hl;
#pragma unroll
                  for (int ks = 0; ks < 8; ++ks) pa[ks] = *(const bf16x8*)(wsp + 16 * ks); }
                { const int q = tid >> 2, qt = tid & 3;
                  const bf16_t* vp = Z + (size_t)(R0 + q) * EV_IN + 4096 + h * 512 + qt * 128;
                  u32x4 vv[16]; float ss = 0.f;
#pragma unroll
                  for (int i = 0; i < 16; ++i) { vv[i] = *(const u32x4*)(vp + i * 8);
                      const float a0 = bf_lo(vv[i].x), a1 = bf_hi(vv[i].x), a2 = bf_lo(vv[i].y), a3 = bf_hi(vv[i].y), a4 = bf_lo(vv[i].z), a5 = bf_hi(vv[i].z), a6 = bf_lo(vv[i].w), a7 = bf_hi(vv[i].w);
                      ss += (a0 * a0 + a1 * a1) + (a2 * a2 + a3 * a3) + (a4 * a4 + a5 * a5) + (a6 * a6 + a7 * a7); }
                  ss += __shfl_xor(ss, 1); ss += __shfl_xor(ss, 2);
                  const float rstd = 1.0f / sqrtf(ss * (1.0f / 512.0f) + EPS);
                  const float* ng = args.in[I_SGUNG] + h * 512 + qt * 128;
                  LAS unsigned char* tile = L + (qt * 2 + (q >> 6)) * 16384;
#pragma unroll
                  for (int i = 0; i < 16; ++i) { const f32x4 g0 = *(const f32x4*)(ng + i * 8), g1 = *(const f32x4*)(ng + i * 8 + 4);
                      u32x4 o; o.x = cvt_pk_bf16(bf_lo(vv[i].x) * rstd * g0.x, bf_hi(vv[i].x) * rstd * g0.y); o.y = cvt_pk_bf16(bf_lo(vv[i].y) * rstd * g0.z, bf_hi(vv[i].y) * rstd * g0.w);
                      o.z = cvt_pk_bf16(bf_lo(vv[i].z) * rstd * g1.x, bf_hi(vv[i].z) * rstd * g1.y); o.w = cvt_pk_bf16(bf_lo(vv[i].w) * rstd * g1.z, bf_hi(vv[i].w) * rstd * g1.w);
                      *(LAS u32x4*)(tile + att::v_st(q & 63, i * 8)) = o; } }
                __syncthreads();
                const float* bsp = args.in[I_SGUB] + h * 128 + 32 * wp;
#pragma unroll
                for (int dbi = 0; dbi < 2; ++dbi) {
                    const int db = 2 * wd + dbi;
                    const float bb = bsp[r32]; const size_t ro = (size_t)(R0 + 32 * wp + r32);
                    const bf16_t* up = Z + ro * EV_IN + 2048 + h * 512 + db * 128 + 4 * hl; bf16_t* yp = YC + ro * D + 2048 + h * 512 + db * 128 + 4 * hl;
                    u32x2 uu[4][4];
#pragma unroll
                    for (int d0 = 0; d0 < 4; ++d0)
#pragma unroll
                        for (int g = 0; g < 4; ++g) uu[d0][g] = *(const u32x2*)(up + d0 * 32 + 8 * g);
                    f32x16 o[4] = {};
                    const int vb = (int)(uintptr_t)(lds + (db * 2) * 16384) + att::v_rd_base(lane);
                    att::pvT_d0(o, vb, pa[0], pa[1], pa[2], pa[3]);
                    att::pvT_d0(o, vb + 16384, pa[4], pa[5], pa[6], pa[7]);
                    asm volatile("" ::: "memory");
#pragma unroll
                    for (int d0 = 0; d0 < 4; ++d0)
#pragma unroll
                        for (int g = 0; g < 4; ++g) { const u32x2 u2 = uu[d0][g];
                            u32x2 w; w.x = cvt_pk_bf16(bf_lo(u2.x) * (o[d0][4 * g + 0] + bb), bf_hi(u2.x) * (o[d0][4 * g + 1] + bb)); w.y = cvt_pk_bf16(bf_lo(u2.y) * (o[d0][4 * g + 2] + bb), bf_hi(u2.y) * (o[d0][4 * g + 3] + bb));
                            *(u32x2*)(yp + d0 * 32 + 8 * g) = w; }
                }
                __syncthreads();
            }
        }
    }
    SEAM(3);

    if (IN(4)) {
        pg8::Gemm g{PA, W_POOL, 2048, 512, 512, 1, 512}; pg8::OrderAll S{8, G, bx}; pg8::EpiPool E{YC, D, args.in[I_POOLS]};
        pg8::gemm_phase(L, g, S, E, wave);
    }
    SEAM(4);

    if (IN(5)) {
        pg8::Gemm g{YC, W_EVOUT, D, D, D, 30, 0}; pg8::OrderXSplitCtx<4> S{G, bx, D / 64}; pg8::EpiResGate E{X, args.in[I_X], args.in[I_CTX], MOD + 2 * D, true, XB, PART};
        pg8::gemm_phase(L, g, S, E, wave);
    }
    SEAM(5);

    if (IN(6)) { const int tid = launder_tid(wave), lane = tid & 63; (void)tid; (void)lane; norm_coop_x(XB, H, args.in[I_N2G], MOD + 3 * D, vcu, G, wave, (LAS float*)L); NORM_CTX_COMBINE(0, 1, true, MOD + (size_t)8 * MODW + 2 * D, true); }
    SEAM(6);

    if (IN(7)) {
        if (bx < G - NH_P7) { pg8::Gemm g{H, (const bf16_t*)(ws + WS_WGU), D, D, D, 30, 0}; pg8::OrderAll S{FFN2 / 256, G - NH_P7, bx}; pg8::EpiSwiGLU E{HID, FFH};
            pg8::gemm_phase(L, g, S, E, wave);
            if (threadIdx.x == 0) __hip_atomic_fetch_add(ctl + CW_HDONE, 1u, __ATOMIC_RELAXED, __HIP_MEMORY_SCOPE_AGENT); }
        else { conv_range(cc, CV_P7_LO, CV_P7_HI, bx - (G - NH_P7), NH_P7, wave, L);
               conv_range<true>(cc, CV_OPT_LO, CV_OPT_HI, bx - (G - NH_P7), NH_P7, wave, L, ctl + CW_HDONE, (unsigned)(G - NH_P7), (int*)(ctl + CW_HSTOP) + (bx - (G - NH_P7)) * 8 + wave); }
    }
    SEAM(7);

    if (IN(8)) {
        pg8::Gemm g{HID, (const bf16_t*)(ws + WS_WDOWN), FFH, FFH, FFH, 30, 0}; pg8::OrderXSplitCtx<2> S{G, bx, FFH / 64};     pg8::EpiResGate E{X, nullptr, nullptr, MOD + 5 * D, false, XB, PART};
        pg8::gemm_phase(L, g, S, E, wave);
    }
    SEAM(8);

    if (IN(9)) { const int tid = launder_tid(wave), lane = tid & 63; (void)tid; (void)lane; norm_coop_x(XB, H, args.in[I_N1G] + D, MOD + (size_t)9 * MODW, vcu, G, wave, (LAS float*)L); NORM_CTX_COMBINE(1, 0, false, MOD + (size_t)8 * MODW + 5 * D, false); }
    SEAM(9);

    if (IN(10)) {
        pg8::Gemm g{H, W_ODIN, D, D, D, 30, 0}; pg8::OrderOdIn S{G, bx}; pg8::EpiBf16 E{Z, ODIN_P, 1 << 30};
        pg8::gemm_phase(L, g, S, E, wave);
    }
    SEAM(10);

    if (IN(11)) { const int tid = launder_tid(wave), lane = tid & 63; (void)tid;
        const float* cosG = ROPEG; const float* sinG = ROPEG + 2048 * 64; const float* cosM = ROPEM; const float* sinM = ROPEM + 2048 * 32;
        const int hh = lane >> 4, jj = lane & 15;
        float gqa[16]; { const float* gp = args.in[I_QAG] + lane * 16;
#pragma unroll
            for (int e = 0; e < 16; ++e) gqa[e] = gp[e]; }
        float gkva[8]; { const float* gp = args.in[I_KVAG] + lane * 8;
#pragma unroll
            for (int e = 0; e < 8; ++e) gkva[e] = gp[e]; }
        const f32x4 gq1 = *(const f32x4*)(args.in[I_QNG] + 4 * jj), gq2 = *(const f32x4*)(args.in[I_QNG] + 64 + 4 * jj);
        const f32x4 gk1 = *(const f32x4*)(args.in[I_KNG] + 4 * jj), gk2 = *(const f32x4*)(args.in[I_KNG] + 64 + 4 * jj);
        for (int R = gw; R < MALL; R += NGW) {
            const int j = R % LT; const bool isx = j >= CTXL; const int t = isx ? j - CTXL : 0;
            bf16_t* zr = Z + (size_t)R * ODIN_P;
            u32x4 cq0 = (u32x4){0u, 0u, 0u, 0u}, cq1 = cq0; u32x2 qa[4], qb[4];
            if (isx) { cq0 = *(const u32x4*)(zr + OC_CQ + lane * 16); cq1 = *(const u32x4*)(zr + OC_CQ + lane * 16 + 8);
#pragma unroll
                for (int it = 0; it < 4; ++it) { const bf16_t* hp = zr + OC_GQ + (it * 4 + hh) * 128 + 4 * jj; qa[it] = *(const u32x2*)hp; qb[it] = *(const u32x2*)(hp + 64); } }
            const u32x4 ckv = *(const u32x4*)(zr + OC_CKV + lane * 8);
            bf16_t* kp_ = zr + OC_GK + hh * 128 + 4 * jj;
            const u32x2 ka = *(const u32x2*)kp_, kb = *(const u32x2*)(kp_ + 64);
            f32x4 cs = (f32x4){1.f, 1.f, 1.f, 1.f}, sn = (f32x4){0.f, 0.f, 0.f, 0.f};
            if (isx) { cs = *(const f32x4*)(cosG + t * 64 + 4 * jj); sn = *(const f32x4*)(sinG + t * 64 + 4 * jj); }
            bf16_t* krp = zr + OC_KR; float kr1 = 0.f, kr2 = 0.f, kcs = 1.f, ksn = 0.f;
            if (isx && lane < 32) { kr1 = bf2f(krp[lane]); kr2 = bf2f(krp[lane + 32]); kcs = cosM[t * 32 + lane]; ksn = sinM[t * 32 + lane]; }
            if (isx) {
                { float f[16] = {bf_lo(cq0.x), bf_hi(cq0.x), bf_lo(cq0.y), bf_hi(cq0.y), bf_lo(cq0.z), bf_hi(cq0.z), bf_lo(cq0.w), bf_hi(cq0.w), bf_lo(cq1.x), bf_hi(cq1.x), bf_lo(cq1.y), bf_hi(cq1.y), bf_lo(cq1.z), bf_hi(cq1.z), bf_lo(cq1.w), bf_hi(cq1.w)};
                  float ss = 0.f;
#pragma unroll
                  for (int e = 0; e < 16; ++e) ss += f[e] * f[e];
                  const float rstd = 1.0f / sqrtf(wave_sum(ss) * (1.0f / 1024.0f) + EPS);
#pragma unroll
                  for (int e = 0; e < 16; ++e) f[e] = f[e] * rstd * gqa[e];
                  u32x4 o0, o1; o0.x = cvt_pk_bf16(f[0], f[1]); o0.y = cvt_pk_bf16(f[2], f[3]); o0.z = cvt_pk_bf16(f[4], f[5]); o0.w = cvt_pk_bf16(f[6], f[7]);
                  o1.x = cvt_pk_bf16(f[8], f[9]); o1.y = cvt_pk_bf16(f[10], f[11]); o1.z = cvt_pk_bf16(f[12], f[13]); o1.w = cvt_pk_bf16(f[14], f[15]);
                  *(u32x4*)(zr + OC_CQ + lane * 16) = o0; *(u32x4*)(zr + OC_CQ + lane * 16 + 8) = o1; }
#pragma unroll
                for (int it = 0; it < 4; ++it) { bf16_t* hp = zr + OC_GQ + (it * 4 + hh) * 128 + 4 * jj;
                    const float x1[4] = {bf_lo(qa[it].x), bf_hi(qa[it].x), bf_lo(qa[it].y), bf_hi(qa[it].y)}, x2[4] = {bf_lo(qb[it].x), bf_hi(qb[it].x), bf_lo(qb[it].y), bf_hi(qb[it].y)};
                    float ss = 0.f;
#pragma unroll
                    for (int e = 0; e < 4; ++e) ss += x1[e] * x1[e] + x2[e] * x2[e];
                    ss += __shfl_xor(ss, 1); ss += __shfl_xor(ss, 2); ss += __shfl_xor(ss, 4); ss += __shfl_xor(ss, 8);
                    const float rstd = 1.0f / sqrtf(ss * (1.0f / 128.0f) + EPS);
                    float y1[4], y2[4];
#pragma unroll
                    for (int e = 0; e < 4; ++e) { const float a1 = x1[e] * rstd * gq1[e], a2 = x2[e] * rstd * gq2[e]; y1[e] = a1 * cs[e] - a2 * sn[e]; y2[e] = a1 * sn[e] + a2 * cs[e]; }
                    u32x2 o1, o2; o1.x = cvt_pk_bf16(y1[0], y1[1]); o1.y = cvt_pk_bf16(y1[2], y1[3]); o2.x = cvt_pk_bf16(y2[0], y2[1]); o2.y = cvt_pk_bf16(y2[2], y2[3]);
                    *(u32x2*)hp = o1; *(u32x2*)(hp + 64) = o2; }
            }
            { float f[8] = {bf_lo(ckv.x), bf_hi(ckv.x), bf_lo(ckv.y), bf_hi(ckv.y), bf_lo(ckv.z), bf_hi(ckv.z), bf_lo(ckv.w), bf_hi(ckv.w)};
              float ss = 0.f;
#pragma unroll
              for (int e = 0; e < 8; ++e) ss += f[e] * f[e];
              const float rstd = 1.0f / sqrtf(wave_sum(ss) * (1.0f / 512.0f) + EPS);
#pragma unroll
              for (int e = 0; e < 8; ++e) f[e] = f[e] * rstd * gkva[e];
              u32x4 o; o.x = cvt_pk_bf16(f[0], f[1]); o.y = cvt_pk_bf16(f[2], f[3]); o.z = cvt_pk_bf16(f[4], f[5]); o.w = cvt_pk_bf16(f[6], f[7]);
              *(u32x4*)(zr + OC_CKV + lane * 8) = o; }
            { const float x1[4] = {bf_lo(ka.x), bf_hi(ka.x), bf_lo(ka.y), bf_hi(ka.y)}, x2[4] = {bf_lo(kb.x), bf_hi(kb.x), bf_lo(kb.y), bf_hi(kb.y)};
              float ss = 0.f;
#pragma unroll
              for (int e = 0; e < 4; ++e) ss += x1[e] * x1[e] + x2[e] * x2[e];
              ss += __shfl_xor(ss, 1); ss += __shfl_xor(ss, 2); ss += __shfl_xor(ss, 4); ss += __shfl_xor(ss, 8);
              const float rstd = 1.0f / sqrtf(ss * (1.0f / 128.0f) + EPS);
              float y1[4], y2[4];
#pragma unroll
              for (int e = 0; e < 4; ++e) { const float a1 = x1[e] * rstd * gk1[e], a2 = x2[e] * rstd * gk2[e]; y1[e] = a1 * cs[e] - a2 * sn[e]; y2[e] = a1 * sn[e] + a2 * cs[e]; }
              u32x2 o1, o2; o1.x = cvt_pk_bf16(y1[0], y1[1]); o1.y = cvt_pk_bf16(y1[2], y1[3]); o2.x = cvt_pk_bf16(y2[0], y2[1]); o2.y = cvt_pk_bf16(y2[2], y2[3]);
              *(u32x2*)kp_ = o1; *(u32x2*)(kp_ + 64) = o2; }
            if (isx && lane < 32) { krp[lane] = f2bf(kr1 * kcs - kr2 * ksn); krp[lane + 32] = f2bf(kr1 * ksn + kr2 * kcs); }
        }
    }
    SEAM(11);

    if (IN(12)) {
        { pg8::Gemm g{Z + OC_CQ, W_QB, ODIN_P, 1024, 1024, 30, 0}; pg8::OrderX<> S{QMW / 256, G, bx}; pg8::EpiBf16 E{QM, QMW, 1 << 30};
          pg8::gemm_phase(L, g, S, E, wave); }
        { pg8::Gemm g{Z + OC_CKV, W_KVB, ODIN_P, 512, 512, 30, 0}; pg8::OrderAll S{KVW / 256, G, bx}; pg8::EpiBf16 E{KVM, KVW, 1 << 30};
          pg8::gemm_phase(L, g, S, E, wave); }
    }
    SEAM(12);


    if (IN(14)) {
        const int xg = bx & 7, kk = bx >> 3;
        const int nper = G >> 3;
        for (int i = 0; ; ++i) {
            const int un = (i * 8 + xg) * nper + kk; if (un >= 1024) break;
            const int bh = un >> 3, qb = un & 7, b = bh >> 4, h = bh & 15;
            const size_t krow0 = (size_t)b * LT, qrow0 = krow0 + CTXL + (size_t)qb * 256;
            att::attn_body<192, MLA_SDEPTH, QMW, KVW, ODIN_P, KVW, D>(QM + qrow0 * QMW + h * 192, KVM + krow0 * KVW + h * 256, Z + krow0 * ODIN_P + OC_KR, KVM + krow0 * KVW + h * 256 + 128,
                                                           YC + qrow0 * D + h * 128, LT, 0.07216878364870322f, (char*)lds, wave, ROPEM + (size_t)qb * 256 * 32, ROPEM + 2048 * 32 + (size_t)qb * 256 * 32);
        }
        for (int i = 0; ; ++i) {
            const int un = (i * 8 + xg) * nper + kk; if (un >= 1024) break;
            const int grp = un >> 5, r = un & 31, b = grp >> 2, kvh = grp & 3, h = kvh * 4 + (r >> 3), qb = r & 7;
            const size_t krow0 = (size_t)b * LT, qrow0 = krow0 + CTXL + (size_t)qb * 256;
            att::attn_body<128, GQA_SDEPTH, ODIN_P, ODIN_P, ODIN_P, ODIN_P, D>(Z + qrow0 * ODIN_P + OC_GQ + h * 128, Z + krow0 * ODIN_P + OC_GK + kvh * 128, nullptr, Z + krow0 * ODIN_P + OC_GV + kvh * 128,
                                                                   YC + qrow0 * D + 2048 + h * 128, LT, 0.08838834764831845f, (char*)lds, wave);
        }
    }
    SEAM(14);

    if (IN(15)) {
        pg8::Gemm g{YC, W_ODOUT, D, D, D, 30, 0}; pg8::OrderX<4> S{D / 256, G, bx}; pg8::EpiResGate E{X, nullptr, nullptr, MOD + (size_t)9 * MODW + 2 * D, false, XB, nullptr};
        pg8::gemm_phase(L, g, S, E, wave);
    }
    SEAM(15);

    if (IN(16)) { const int tid = launder_tid(wave), lane = tid & 63; (void)tid; (void)lane; conv_catchup(cc, CV_OPT_HI, NH_P7 * 8, (const int*)(ctl + CW_HSTOP), gw, NGW, wave, L); __syncthreads(); norm_coop_x(XB, H, args.in[I_N2G] + D, MOD + (size_t)9 * MODW + 3 * D, vcu, G, wave, (LAS float*)L); }
    SEAM(16);

    if (IN(17)) {
        if (bx < G - NH_P17) { pg8::Gemm g{H, (const bf16_t*)(ws + WS_WGU + WGU_L), D, D, D, 30, 0}; pg8::OrderX<> S{FFN2 / 256, G - NH_P17, bx}; pg8::EpiSwiGLU E{HID, FFH};
            pg8::gemm_phase(L, g, S, E, wave); }
        else conv_range(cc, CV_P17_LO, CV_P17_HI, bx - (G - NH_P17), NH_P17, wave, L);
    }
    SEAM(17);

    if (IN(18)) {
        pg8::Gemm g{HID, (const bf16_t*)(ws + WS_WDOWN + WDOWN_L), FFH, FFH, FFH, 30, 0}; pg8::OrderX<2> S{D / 256, G, bx}; pg8::EpiResGate E{X, nullptr, nullptr, MOD + (size_t)9 * MODW + 5 * D, false, XB, nullptr};
        pg8::gemm_phase(L, g, S, E, wave);
    }
    SEAM(18);

    if (IN(19)) { const int tid = launder_tid(wave), lane = tid & 63; (void)tid; (void)lane;
        const float* gvec = args.in[I_FING];
        for (int idx = gw; idx < NB * SEQ; idx += NGW) {
            const bf16_t* srow = XB + (size_t)xrow(idx) * D; float* orow = args.out + (size_t)idx * D;
            u32x4 v[8]; float ss = 0.f;
#pragma unroll
            for (int q = 0; q < 8; ++q) { v[q] = *(const u32x4*)(srow + (q * 64 + lane) * 8);
                const float a0 = bf_lo(v[q].x), a1 = bf_hi(v[q].x), a2 = bf_lo(v[q].y), a3 = bf_hi(v[q].y), a4 = bf_lo(v[q].z), a5 = bf_hi(v[q].z), a6 = bf_lo(v[q].w), a7 = bf_hi(v[q].w);
                ss += ((a0 * a0 + a1 * a1) + (a2 * a2 + a3 * a3)) + ((a4 * a4 + a5 * a5) + (a6 * a6 + a7 * a7)); }
            const float rstd = 1.0f / sqrtf(wave_sum(ss) * (1.0f / D) + EPS);
#pragma unroll
            for (int q = 0; q < 8; ++q) { const int c = (q * 64 + lane) * 8;
                const f32x4 x0 = (f32x4){bf_lo(v[q].x), bf_hi(v[q].x), bf_lo(v[q].y), bf_hi(v[q].y)}, x1 = (f32x4){bf_lo(v[q].z), bf_hi(v[q].z), bf_lo(v[q].w), bf_hi(v[q].w)};
                *(f32x4*)(orow + c) = x0 * rstd * *(const f32x4*)(gvec + c); *(f32x4*)(orow + c + 4) = x1 * rstd * *(const f32x4*)(gvec + c + 4); }
        }
    }
#undef IN
#undef SEAM
}

extern "C" void kernel_launch(void* const* d_in, const int* in_sizes, int n_in, void* d_out, int out_size, void* d_ws, size_t ws_size, hipStream_t stream) {
    static int grid = 0;
    if (grid == 0) {
        if (n_in != 26 || out_size != NB * SEQ * D || ws_size < WS_END) { fprintf(stderr, "kernel_launch: unexpected shapes: n_in %d out %d ws %zu (need %zu); nothing launched\n", n_in, out_size, ws_size, (size_t)WS_END); grid = -1; return; }
        int dev = 0, cus = 0;
        if (hipGetDevice(&dev) != hipSuccess || hipDeviceGetAttribute(&cus, hipDeviceAttributeMultiprocessorCount, dev) != hipSuccess) { grid = -1; return; }
        if (hipFuncSetAttribute((const void*)trunk_fwd, hipFuncAttributeMaxDynamicSharedMemorySize, LDS_BYTES) != hipSuccess) { fprintf(stderr, "kernel_launch: hipFuncSetAttribute failed\n"); grid = -1; return; }
        int per_cu = 0;
        if (hipOccupancyMaxActiveBlocksPerMultiprocessor(&per_cu, (const void*)trunk_fwd, 512, LDS_BYTES) != hipSuccess || per_cu < 1) fprintf(stderr, "kernel_launch: occupancy query says %d\n", per_cu);
        (void)hipGetLastError();
        grid = cus;
    }
    if (grid < 0) return;
    (void)hipMemsetAsync((char*)d_ws + WS_CTL, 0, CTL_BYTES, stream);
    Args a{};
    for (int i = 0; i < 26; ++i) a.in[i] = (const float*)d_in[i];
    a.out = (float*)d_out; a.ws = (unsigned char*)d_ws;
#if MK_N_LAUNCHES == 1
    a.ph_lo = 0; a.ph_hi = N_PHASES;
    hipLaunchKernelGGL(trunk_fwd, dim3(grid), dim3(512), LDS_BYTES, stream, a);
#else
    for (int p = 0; p < N_PHASES; ++p) { a.ph_lo = p; a.ph_hi = p + 1; hipLaunchKernelGGL(trunk_fwd, dim3(grid), dim3(512), LDS_BYTES, stream, a); }
#endif
    const hipError_t le = hipPeekAtLastError();
    if (le != hipSuccess) fprintf(stderr, "kernel_launch: launch failed: %s\n", hipGetErrorName(le));
}
```

```cpp
#include <hip/hip_runtime.h>
#include <cstdio>
#include <cstdint>

#ifndef MK_N_LAUNCHES
#define MK_N_LAUNCHES 1
#endif

#define LAS __attribute__((address_space(3)))
#define GAS __attribute__((address_space(1)))
typedef unsigned short bf16_t;
typedef short bf16x8 __attribute__((ext_vector_type(8)));
typedef short s16x4 __attribute__((ext_vector_type(4)));
typedef float f32x2 __attribute__((ext_vector_type(2)));
typedef float f32x4 __attribute__((ext_vector_type(4)));
typedef float f32x16 __attribute__((ext_vector_type(16)));
typedef unsigned u32x2 __attribute__((ext_vector_type(2)));
typedef unsigned u32x4 __attribute__((ext_vector_type(4)));

constexpr int D = 4096, NB = 8, SEQ = 2048, CTXL = 256, LT = SEQ + CTXL  , MALL = NB * LT  ;
constexpr int NPAN = MALL / 256  , NPANX = NB * SEQ / 256  ;
constexpr int MODW = 6 * D;
constexpr int FFH = 11008, FFN2 = 2 * FFH;
constexpr int EV_IN = 6144;
constexpr int ODIN = 4672, ODIN_P = 4864;
constexpr int OC_CQ = 0, OC_GQ = 1024, OC_CKV = 3072, OC_GK = 3584, OC_GV = 4096, OC_KR = 4608;
constexpr int QMW = 3072, KVW = 4096;
constexpr float EPS = 1e-6f;

constexpr size_t MiB = 1u << 20;
constexpr size_t al(size_t x) { return (x + MiB - 1) / MiB * MiB; }
constexpr size_t WS_CTL = 0, CTL_BYTES = 1 * MiB;
constexpr size_t WS_MOD = WS_CTL + CTL_BYTES;
constexpr size_t WS_ROPEM = WS_MOD + al((size_t)2 * 9 * MODW * 4);
constexpr size_t WS_ROPEG = WS_ROPEM + al((size_t)2 * 2048 * 32 * 4);
constexpr size_t WS_WEVIN = WS_ROPEG + al((size_t)2 * 2048 * 64 * 4);
constexpr size_t WS_WEVOUT = WS_WEVIN + al((size_t)EV_IN * D * 2);
constexpr size_t WS_WPOOL = WS_WEVOUT + al((size_t)D * D * 2);
constexpr size_t WS_WSGU = WS_WPOOL + al((size_t)4 * 512 * 512 * 2);
constexpr size_t WS_WGU = WS_WSGU + al((size_t)4 * 128 * 128 * 2);
constexpr size_t WGU_L = (size_t)FFN2 * D * 2;
constexpr size_t WS_WDOWN = WS_WGU + al(2 * WGU_L);
constexpr size_t WDOWN_L = (size_t)D * FFH * 2;
constexpr size_t WS_WODIN = WS_WDOWN + al(2 * WDOWN_L);
constexpr size_t WS_WQB = WS_WODIN + al((size_t)ODIN_P * D * 2);
constexpr size_t WS_WKVB = WS_WQB + al((size_t)QMW * 1024 * 2);
constexpr size_t WS_WODOUT = WS_WKVB + al((size_t)KVW * 512 * 2);
constexpr size_t WS_X = WS_WODOUT + al((size_t)D * D * 2);
constexpr size_t WS_H = WS_X + al((size_t)MALL * D * 4);
constexpr size_t WS_Z = WS_H + al((size_t)MALL * D * 2);
constexpr size_t WS_PA = WS_Z + al((size_t)MALL * EV_IN * 2);
constexpr size_t WS_YC = WS_PA + al((size_t)MALL * 2048 * 2);
constexpr size_t WS_HID = WS_YC + al((size_t)MALL * D * 2);
constexpr size_t WS_QM = WS_HID + al((size_t)MALL * FFH * 2);
constexpr size_t WS_KVM = WS_QM + al((size_t)MALL * QMW * 2);
constexpr size_t WS_XB = WS_KVM + al((size_t)MALL * KVW * 2);
constexpr size_t WS_PART = WS_XB + al((size_t)MALL * D * 2);
constexpr size_t WS_END = WS_PART + al((size_t)2 * NB * CTXL * D * 4);
constexpr int CW_BAR = 4096, CW_HDONE = 80000, CW_HSTOP = 80064;

constexpr int RING_BYTES = 131072, MISC_OFF = RING_BYTES + 320, LDS_BYTES = 147456;

__device__ __forceinline__ unsigned cvt_pk_bf16(float lo, float hi) { unsigned r; asm volatile("v_cvt_pk_bf16_f32 %0, %1, %2" : "=v"(r) : "v"(lo), "v"(hi)); return r; }
__device__ __forceinline__ float bf_lo(unsigned w) { return __uint_as_float(w << 16); }
__device__ __forceinline__ float bf_hi(unsigned w) { return __uint_as_float(w & 0xffff0000u); }
__device__ __forceinline__ float bf2f(bf16_t b) { return __uint_as_float(((unsigned)b) << 16); }
__device__ __forceinline__ bf16_t f2bf(float f) { return (bf16_t)(cvt_pk_bf16(f, 0.f) & 0xffffu); }
__device__ __forceinline__ float wave_sum(float v) {
#pragma unroll
    for (int o = 1; o < 64; o <<= 1) v += __shfl_xor(v, o);
    return v;
}
__device__ __forceinline__ int lane_id() { return (int)__builtin_amdgcn_mbcnt_hi(~0u, __builtin_amdgcn_mbcnt_lo(~0u, 0u)); }
__device__ __forceinline__ int launder_tid(int wave) { int t = wave * 64 + lane_id(); asm volatile("" : "+v"(t)); return t; }
#define LDS_WAIT() asm volatile("s_waitcnt lgkmcnt(0)" ::: "memory")
#define VM_WAIT() asm volatile("s_waitcnt vmcnt(0)" ::: "memory")
__device__ __forceinline__ int xrow(int idx) { return (idx >> 11) * LT + CTXL + (idx & 2047); }
__device__ __forceinline__ int pan_x(int pmx) { return (pmx >> 3) * 9 + 1 + (pmx & 7); }
__device__ __forceinline__ int mod_row_of_panel(int pm) { return (pm % 9 == 0) ? 8 : pm / 9; }

namespace pg8 {
constexpr int BM = 256, BK = 64, HALF = 128, HTB = HALF * BK * 2, STAGE_BYTES = 8 * HTB, NXCD = 8, WGM = 8;
__host__ __device__ __forceinline__ int lds_byte(int r, int c) { const int st = (r >> 4) * 2 + (c >> 5), rr = r & 15, cc = c & 31, ob = rr * 64 + cc * 2; return st * 1024 + (ob ^ (((ob >> 9) & 1) << 5)); }
__host__ __device__ __forceinline__ void stage_rc(int b, int& R, int& C) { const int st = b / 1024, sb = b % 1024, swz = sb ^ (((sb >> 9) & 1) << 5); R = (st >> 1) * 16 + swz / 64; C = (st & 1) * 32 + (swz % 64) / 2; }
__host__ __device__ __forceinline__ int perm32(int rho) { const int n = rho >> 4, i = rho & 15; return 8 * (i >> 2) + 4 * n + (i & 3); }

struct Unit { int pm, pn, k0t, split; };
struct Gemm { const bf16_t* A; const bf16_t* Bt; int lda, ldb, K, ashift, astride; };

template <int WGM_>
__device__ __forceinline__ void grid_unit(int wgid, int nM, int nN, int& pm, int& pn) {
    const int nwg = nM * nN;
    { const int q = nwg / NXCD, r = nwg % NXCD, xcd = wgid % NXCD, off = wgid / NXCD; wgid = (xcd < r ? xcd * (q + 1) : r * (q + 1) + (xcd - r) * q) + off; }
    const int nig = WGM_ * nN, gid = wgid / nig, fm = gid * WGM_, gsz = (nM - fm) < WGM_ ? (nM - fm) : WGM_;
    pm = fm + ((wgid % nig) % gsz); pn = (wgid % nig) / gsz;
}
struct OrderAll {
    int nN, G, c;
    __device__ __forceinline__ bool next(int i, Unit& u) const { const long L = (long)i * G + c; if (c >= G || L >= (long)NPAN * nN) return false; grid_unit<9>((int)L, NPAN, nN, u.pm, u.pn); u.k0t = 0; u.split = 0; return true; }
};
template <int WG_PAN = 8>
struct OrderX {
    int nN, G, c;
    __device__ __forceinline__ bool next(int i, Unit& u) const { const long L = (long)i * G + c; if (c >= G || L >= (long)NPANX * nN) return false; int pm; grid_unit<WG_PAN>((int)L, NPANX, nN, pm, u.pn); u.pm = pan_x(pm); u.k0t = 0; u.split = 0; return true; }
};
template <int WG_PAN = 8>
struct OrderXSplitCtx {
    int G, c, ntk;
    __device__ __forceinline__ bool next(int i, Unit& u) const { const int L = i * G + c;
        if (L < NPANX * 16) { int pm; grid_unit<WG_PAN>(L, NPANX, 16, pm, u.pn); u.pm = pan_x(pm); u.k0t = 0; u.split = 0; return true; }
        const int l2 = L - NPANX * 16; if (l2 >= 256) return false; const int tile = l2 >> 1; u.pm = (tile >> 4) * 9; u.pn = tile & 15; u.k0t = (l2 & 1) * (ntk >> 1); u.split = 1 + (l2 & 1); return true; }
};
struct OrderOdIn {
    int G, c;
    __device__ __forceinline__ bool next(int i, Unit& u) const { const int L = i * G + c; constexpr int NXU = NPANX * 19; u.k0t = 0; u.split = 0;
        if (L < NXU) { int pm; grid_unit<8>(L, NPANX, 19, pm, u.pn); u.pm = pan_x(pm); return true; }
        const int l2 = L - NXU; if (l2 >= 8 * 7) return false; u.pm = (l2 & 7) * 9; u.pn = 12 + (l2 >> 3); return true; }
};

template <class Epi, class Sched>
__device__ __forceinline__ void gemm_phase(LAS unsigned char* lds, const Gemm g, const Sched& S, const Epi& E, const int wave) {
    const int tid = launder_tid(wave), wid = wave, lane = tid & 63, wr = wid >> 2, wc = wid & 3, fr = lane & 15, fq = lane >> 4;
    const int K = g.K, nt = K / BK;
    unsigned voffA[2], voffB[2];
#pragma unroll
    for (int i = 0; i < 2; ++i) { int R, C; stage_rc(tid * 16 + i * 8192, R, C); const int Rb = Epi::PERM ? ((R & ~31) + perm32(R & 31)) : R;
        voffA[i] = (unsigned)(R * g.lda + C) * 2u; voffB[i] = (unsigned)(Rb * g.ldb + C) * 2u; }
    const size_t kstep = (size_t)(BK * 2);
    const size_t hstepA = (size_t)HALF * g.lda * 2, hstepB = (size_t)HALF * g.ldb * 2;
    const unsigned ldsw = (unsigned)wid * 1024u;
    const int aoff = lds_byte(wr * 64 + fr, fq * 8), boff = lds_byte(wc * 32 + fr, fq * 8);
#define PG8_SA(b, h) (((b) * 2 + (h)) * HTB)
#define PG8_SB(b, h) ((4 + (b) * 2 + (h)) * HTB)
#define PG8_STAGE(bufoff, gbase, voff) do { _Pragma("unroll") for (int _i = 0; _i < 2; ++_i) \
        __builtin_amdgcn_global_load_lds((const unsigned*)((const char*)(gbase) + (voff)[_i]), (LAS unsigned*)(lds + (bufoff) + ldsw + _i * 8192), 16, 0, 0); } while (0)
#define PG8_LDA(dst, b, h) do { _Pragma("unroll") for (int m = 0; m < 4; ++m) _Pragma("unroll") for (int k = 0; k < 2; ++k) dst[m][k] = *(const LAS bf16x8*)(lds + PG8_SA(b, h) + aoff + m * 2048 + k * 1024); } while (0)
#define PG8_LDB(dst, b, h) do { _Pragma("unroll") for (int n = 0; n < 2; ++n) _Pragma("unroll") for (int k = 0; k < 2; ++k) dst[n][k] = *(const LAS bf16x8*)(lds + PG8_SB(b, h) + boff + n * 2048 + k * 1024); } while (0)
#define PG8_MMA(ai, bj, At, Bt) do { __builtin_amdgcn_s_setprio(1); _Pragma("unroll") for (int m = 0; m < 4; ++m) _Pragma("unroll") for (int n = 0; n < 2; ++n) _Pragma("unroll") for (int k = 0; k < 2; ++k) \
        acc[ai][bj][m][n] = __builtin_amdgcn_mfma_f32_16x16x32_bf16(Bt[n][k], At[m][k], acc[ai][bj][m][n], 0, 0, 0); __builtin_amdgcn_s_setprio(0); } while (0)
#define PG8_WAIT_V(n) asm volatile("s_waitcnt vmcnt(" #n ")" ::: "memory")
#define PG8_WAIT_L(n) asm volatile("s_waitcnt lgkmcnt(" #n ")" ::: "memory")
#define PG8_BAR __builtin_amdgcn_s_barrier()
#define PG8_SCHED __builtin_amdgcn_sched_barrier(0)
    Unit cur, nxt; int ui = 0;
    if (!S.next(0, cur)) return;
    f32x4 acc[2][2][4][2];
#pragma unroll
    for (int a = 0; a < 2; ++a)
#pragma unroll
        for (int b = 0; b < 2; ++b)
#pragma unroll
            for (int m = 0; m < 4; ++m)
#pragma unroll
                for (int n = 0; n < 2; ++n) acc[a][b][m][n] = (f32x4){0.f, 0.f, 0.f, 0.f};
    bf16x8 At[4][2], B0[2][2], B1[2][2];
    const char* cA = (const char*)g.A + (size_t)cur.pm * 2 * hstepA + (size_t)(cur.pn >> g.ashift) * g.astride * 2 + (size_t)cur.k0t * kstep;
    const char* cB = (const char*)g.Bt + (size_t)cur.pn * 2 * hstepB + (size_t)cur.k0t * kstep;
    PG8_STAGE(PG8_SB(0, 0), cB, voffB); PG8_STAGE(PG8_SB(0, 1), cB + hstepB, voffB); PG8_STAGE(PG8_SA(0, 0), cA, voffA); PG8_STAGE(PG8_SA(0, 1), cA + hstepA, voffA);
    if (wr == 1) PG8_BAR;
    PG8_WAIT_V(2); PG8_BAR;
    PG8_STAGE(PG8_SB(1, 0), cB + kstep, voffB); PG8_STAGE(PG8_SA(1, 0), cA + kstep, voffA); PG8_STAGE(PG8_SB(1, 1), cB + hstepB + kstep, voffB);
    PG8_WAIT_V(6); PG8_BAR;
    for (;;) {
        const bool has_next = S.next(ui + 1, nxt);
        const char* nA = has_next ? (const char*)g.A + (size_t)nxt.pm * 2 * hstepA + (size_t)(nxt.pn >> g.ashift) * g.astride * 2 + (size_t)nxt.k0t * kstep : cA;
        const char* nB = has_next ? (const char*)g.Bt + (size_t)nxt.pn * 2 * hstepB + (size_t)nxt.k0t * kstep : cB;
        const int unt = cur.split ? (nt >> 1) : nt;
        for (int t = 0; t < unt; t += 2) {
            const bool last = (t == unt - 2);
            const char* a1 = cA + (size_t)(t + 1) * kstep;
            const char* a2 = last ? nA : cA + (size_t)(t + 2) * kstep; const char* b2 = last ? nB : cB + (size_t)(t + 2) * kstep;
            const char* a3 = a2 + kstep; const char* b3 = b2 + kstep;
            PG8_LDB(B0, 0, 0); PG8_LDB(B1, 0, 1); PG8_SCHED; PG8_LDA(At, 0, 0); PG8_STAGE(PG8_SA(1, 1), a1 + hstepA, voffA);
            PG8_WAIT_V(8); PG8_WAIT_L(0); PG8_BAR; PG8_MMA(0, 0, At, B0); PG8_MMA(0, 1, At, B1); PG8_BAR; PG8_SCHED;
            PG8_LDA(At, 0, 1); PG8_STAGE(PG8_SB(0, 0), b2, voffB); PG8_STAGE(PG8_SB(0, 1), b2 + hstepB, voffB); PG8_STAGE(PG8_SA(0, 0), a2, voffA);
            PG8_WAIT_V(8); PG8_WAIT_L(0); PG8_BAR; PG8_MMA(1, 0, At, B0); PG8_MMA(1, 1, At, B1); PG8_BAR; PG8_SCHED;
            PG8_LDB(B0, 1, 0); PG8_LDB(B1, 1, 1); PG8_SCHED; PG8_LDA(At, 1, 0); PG8_STAGE(PG8_SA(0, 1), a2 + hstepA, voffA);
            PG8_WAIT_V(8); PG8_WAIT_L(0); PG8_BAR; PG8_MMA(0, 0, At, B0); PG8_MMA(0, 1, At, B1); PG8_BAR; PG8_SCHED;
            PG8_LDA(At, 1, 1); PG8_STAGE(PG8_SB(1, 0), b3, voffB); PG8_STAGE(PG8_SB(1, 1), b3 + hstepB, voffB); PG8_STAGE(PG8_SA(1, 0), a3, voffA);
            PG8_WAIT_V(8); PG8_WAIT_L(0); PG8_BAR; PG8_MMA(1, 0, At, B0); PG8_MMA(1, 1, At, B1); PG8_BAR; PG8_SCHED;
        }
        if (wr == 0) PG8_BAR;
        E(acc, cur, wr, wc, fr, fq);
        if (!has_next) break;
#pragma unroll
        for (int a = 0; a < 2; ++a)
#pragma unroll
            for (int b = 0; b < 2; ++b)
#pragma unroll
                for (int m = 0; m < 4; ++m)
#pragma unroll
                    for (int n = 0; n < 2; ++n) acc[a][b][m][n] = (f32x4){0.f, 0.f, 0.f, 0.f};
        cur = nxt; cA = nA; cB = nB; ++ui;
        if (wr == 1) PG8_BAR;
    }
    PG8_WAIT_V(0);
    PG8_BAR;
#undef PG8_SA
#undef PG8_SB
#undef PG8_STAGE
#undef PG8_LDA
#undef PG8_LDB
#undef PG8_MMA
#undef PG8_WAIT_V
#undef PG8_WAIT_L
#undef PG8_BAR
#undef PG8_SCHED
}

__device__ __forceinline__ f32x2 gelu_tanh_pk(f32x2 x) {
    const f32x2 x2 = x * x, p = x2 * 0.044715f + 1.0f, t = (x * p) * (-2.3022081986f);
    f32x2 e; e.x = __builtin_amdgcn_exp2f(t.x); e.y = __builtin_amdgcn_exp2f(t.y);
    const f32x2 d = e + 1.0f;
    f32x2 r; r.x = __builtin_amdgcn_rcpf(d.x); r.y = __builtin_amdgcn_rcpf(d.y);
    return x * r;
}
struct EpiBf16 {
    static constexpr bool PERM = true;
    bf16_t* O; int ldc; int act_from;
    __device__ __forceinline__ void operator()(const f32x4 (&acc)[2][2][4][2], const Unit& u, int wr, int wc, int fr, int fq) const {
        const int row0 = u.pm * BM + wr * 64 + fr, col0 = u.pn * BM + wc * 32 + 8 * fq; const bool act = u.pn >= act_from;
#pragma unroll
        for (int ai = 0; ai < 2; ++ai)
#pragma unroll
            for (int m = 0; m < 4; ++m) { bf16_t* rowp = O + (size_t)(row0 + ai * HALF + m * 16) * ldc + col0;
#pragma unroll
                for (int bj = 0; bj < 2; ++bj) { f32x4 v0 = acc[ai][bj][m][0], v1 = acc[ai][bj][m][1];
                    if (act) { const f32x2 a = gelu_tanh_pk((f32x2){v0[0], v0[1]}), b = gelu_tanh_pk((f32x2){v0[2], v0[3]}), c = gelu_tanh_pk((f32x2){v1[0], v1[1]}), d = gelu_tanh_pk((f32x2){v1[2], v1[3]});
                        v0 = (f32x4){a.x, a.y, b.x, b.y}; v1 = (f32x4){c.x, c.y, d.x, d.y}; }
                    u32x4 w; w.x = cvt_pk_bf16(v0[0], v0[1]); w.y = cvt_pk_bf16(v0[2], v0[3]); w.z = cvt_pk_bf16(v1[0], v1[1]); w.w = cvt_pk_bf16(v1[2], v1[3]);
                    *(u32x4*)(rowp + bj * HALF) = w; } }
    }
};
struct EpiPool {
    static constexpr bool PERM = true;
    bf16_t* O; int ldc; const float* scale;
    __device__ __forceinline__ void operator()(const f32x4 (&acc)[2][2][4][2], const Unit& u, int wr, int wc, int fr, int fq) const {
        const int row0 = u.pm * BM + wr * 64 + fr, col0 = u.pn * BM + wc * 32 + 8 * fq;
        f32x4 sv[2][2];
#pragma unroll
        for (int bj = 0; bj < 2; ++bj)
#pragma unroll
            for (int n = 0; n < 2; ++n) sv[bj][n] = *(const f32x4*)(scale + col0 + bj * HALF + 4 * n);
#pragma unroll
        for (int ai = 0; ai < 2; ++ai)
#pragma unroll
            for (int m = 0; m < 4; ++m) { bf16_t* rowp = O + (size_t)(row0 + ai * HALF + m * 16) * ldc + col0;
#pragma unroll
                for (int bj = 0; bj < 2; ++bj) { const f32x4 v0 = acc[ai][bj][m][0] * sv[bj][0], v1 = acc[ai][bj][m][1] * sv[bj][1];
                    u32x4 w; w.x = cvt_pk_bf16(v0[0], v0[1]); w.y = cvt_pk_bf16(v0[2], v0[3]); w.z = cvt_pk_bf16(v1[0], v1[1]); w.w = cvt_pk_bf16(v1[2], v1[3]);
                    *(u32x4*)(rowp + bj * HALF) = w; } }
    }
};
__device__ __forceinline__ f32x2 swiglu_pk(f32x2 g, f32x2 u) {
    const f32x2 t = g * (-1.4426950408889634f);
    f32x2 e; e.x = __builtin_amdgcn_exp2f(t.x); e.y = __builtin_amdgcn_exp2f(t.y);
    const f32x2 d = e + 1.0f;
    f32x2 r; r.x = __builtin_amdgcn_rcpf(d.x); r.y = __builtin_amdgcn_rcpf(d.y);
    return (g * u) * r;
}
struct EpiSwiGLU {
    static constexpr bool PERM = true;
    bf16_t* O; int ldc;
    __device__ __forceinline__ void operator()(const f32x4 (&acc)[2][2][4][2], const Unit& u, int wr, int wc, int fr, int fq) const {
        const int row0 = u.pm * BM + wr * 64 + fr, col0 = u.pn * HALF + wc * 32 + 8 * fq;
#pragma unroll
        for (int ai = 0; ai < 2; ++ai)
#pragma unroll
            for (int m = 0; m < 4; ++m) { bf16_t* rowp = O + (size_t)(row0 + ai * HALF + m * 16) * ldc + col0;
                const f32x4 g0 = acc[ai][0][m][0], g1 = acc[ai][0][m][1], u0 = acc[ai][1][m][0], u1 = acc[ai][1][m][1];
                const f32x2 h0 = swiglu_pk((f32x2){g0[0], g0[1]}, (f32x2){u0[0], u0[1]}), h1 = swiglu_pk((f32x2){g0[2], g0[3]}, (f32x2){u0[2], u0[3]});
                const f32x2 h2 = swiglu_pk((f32x2){g1[0], g1[1]}, (f32x2){u1[0], u1[1]}), h3 = swiglu_pk((f32x2){g1[2], g1[3]}, (f32x2){u1[2], u1[3]});
                u32x4 w; w.x = cvt_pk_bf16(h0.x, h0.y); w.y = cvt_pk_bf16(h1.x, h1.y); w.z = cvt_pk_bf16(h2.x, h2.y); w.w = cvt_pk_bf16(h3.x, h3.y);
                *(u32x4*)rowp = w; }
    }
};
struct EpiResGate {
    static constexpr bool PERM = true;
    float* X; const float* xin; const float* ctxin; const float* gate; bool from_input; bf16_t* XB; float* PART;
    __device__ __forceinline__ void operator()(const f32x4 (&acc)[2][2][4][2], const Unit& u, int wr, int wc, int fr, int fq) const {
        const int lrow0 = wr * 64 + fr, col0 = u.pn * BM + wc * 32 + 8 * fq;
        const int b = u.pm / 9, p = u.pm % 9;
        if (u.split) {
            float* po = PART + ((size_t)(u.split - 1) * NB * CTXL + (size_t)b * CTXL) * D + col0;
#pragma unroll
            for (int ai = 0; ai < 2; ++ai)
#pragma unroll
                for (int m = 0; m < 4; ++m) { const size_t ro = (size_t)(lrow0 + ai * HALF + m * 16) * D;
#pragma unroll
                    for (int bj = 0; bj < 2; ++bj) { *(f32x4*)(po + ro + bj * HALF) = acc[ai][bj][m][0]; *(f32x4*)(po + ro + bj * HALF + 4) = acc[ai][bj][m][1]; } }
            return;
        }
        const float* gp = gate + (size_t)(p == 0 ? 8 : b) * MODW + col0;
        const float* bs = from_input ? (p == 0 ? ctxin + (size_t)b * CTXL * D : xin + ((size_t)b * SEQ + (size_t)(p - 1) * 256) * D) + col0 : nullptr;
        bf16_t* xb = XB + (size_t)u.pm * BM * D + col0;
        f32x4 gv[2][2];
#pragma unroll
        for (int bj = 0; bj < 2; ++bj)
#pragma unroll
            for (int n = 0; n < 2; ++n) gv[bj][n] = *(const f32x4*)(gp + bj * HALF + n * 4);
#pragma unroll
        for (int q = 0; q < 4; ++q) {
            const int ai = q >> 1, m0 = (q & 1) * 2;
            f32x4 bv[2][2][2];
            if (from_input) {
#pragma unroll
                for (int mm = 0; mm < 2; ++mm) { const size_t ro = (size_t)(lrow0 + ai * HALF + (m0 + mm) * 16) * D;
#pragma unroll
                    for (int bj = 0; bj < 2; ++bj) { bv[mm][bj][0] = *(const f32x4*)(bs + ro + bj * HALF); bv[mm][bj][1] = *(const f32x4*)(bs + ro + bj * HALF + 4); } }
            } else {
                u32x4 bw[2][2];
#pragma unroll
                for (int mm = 0; mm < 2; ++mm) { const size_t ro = (size_t)(lrow0 + ai * HALF + (m0 + mm) * 16) * D;
#pragma unroll
                    for (int bj = 0; bj < 2; ++bj) bw[mm][bj] = *(const u32x4*)(xb + ro + bj * HALF); }
#pragma unroll
                for (int mm = 0; mm < 2; ++mm)
#pragma unroll
                    for (int bj = 0; bj < 2; ++bj) { const u32x4 w = bw[mm][bj];
                        bv[mm][bj][0] = (f32x4){bf_lo(w.x), bf_hi(w.x), bf_lo(w.y), bf_hi(w.y)}; bv[mm][bj][1] = (f32x4){bf_lo(w.z), bf_hi(w.z), bf_lo(w.w), bf_hi(w.w)}; }
            }
            asm volatile("" ::: "memory");
#pragma unroll
            for (int mm = 0; mm < 2; ++mm) { const int m = m0 + mm; const size_t ro = (size_t)(lrow0 + ai * HALF + m * 16) * D;
#pragma unroll
                for (int bj = 0; bj < 2; ++bj) {
                    const f32x4 o0 = bv[mm][bj][0] + gv[bj][0] * acc[ai][bj][m][0], o1 = bv[mm][bj][1] + gv[bj][1] * acc[ai][bj][m][1];
                    u32x4 w; w.x = cvt_pk_bf16(o0[0], o0[1]); w.y = cvt_pk_bf16(o0[2], o0[3]); w.z = cvt_pk_bf16(o1[0], o1[1]); w.w = cvt_pk_bf16(o1[2], o1[3]); *(u32x4*)(xb + ro + bj * HALF) = w; } }
            asm volatile("" ::: "memory");
        }
    }
};
}

namespace att {
constexpr int NW = 8, QBLK = 32, KVBLK = 64;
constexpr int SHM_V = KVBLK * 128 * 2, SHM_K = KVBLK * 128 * 2, SHM_K2 = KVBLK * 64 * 2;
constexpr int OFF_V = 0, OFF_K = 2 * SHM_V, OFF_K2 = OFF_K + 2 * SHM_K, OFF_WS = OFF_K2 + 2 * SHM_K2, OFF_QR = OFF_WS + NW * 64 * 4, ATT_LDS = OFF_QR + NW * 4096;
#define KSWZ(row, colB) ((row) * 256 + ((colB) ^ (((row) & 7) << 4)))
#define KSWZ2(row, colB) ((row) * 128 + ((colB) ^ ((((row) >> 1) & 7) << 4)))
#define SBAR() __builtin_amdgcn_sched_barrier(0)
__device__ __forceinline__ int crow(int r, int hi) { return (r & 3) + 8 * (r >> 2) + 4 * hi; }
__device__ __forceinline__ void partialSM(f32x16& p0, f32x16& p1, float& m_reg, float& mn, float& alpha, const float C, const float thr_s) {
  float pmax = p0[0];
#pragma unroll
  for (int r = 1; r < 16; ++r) pmax = fmaxf(pmax, p0[r]);
#pragma unroll
  for (int r = 0; r < 16; ++r) pmax = fmaxf(pmax, p1[r]);
  { auto rr = __builtin_amdgcn_permlane32_swap(__float_as_uint(pmax), __float_as_uint(pmax), false, false);
    pmax = fmaxf(__uint_as_float(rr[0]), __uint_as_float(rr[1])); }
  if (__builtin_expect(__all(pmax - m_reg <= thr_s), 1)) { mn = m_reg; alpha = 1.f; }
  else { mn = fmaxf(m_reg, pmax); alpha = __builtin_amdgcn_exp2f((m_reg - mn) * C); m_reg = mn; }
  const float mnC = -mn * C;
#pragma unroll
  for (int r = 0; r < 16; ++r) p0[r] = fmaf(p0[r], C, mnC);
#pragma unroll
  for (int r = 0; r < 16; ++r) p1[r] = fmaf(p1[r], C, mnC);
#pragma unroll
  for (int r = 0; r < 16; ++r) p0[r] = __builtin_amdgcn_exp2f(p0[r]);
}
__device__ __forceinline__ void finishSM(f32x16& p0, f32x16& p1, float alpha, float& l_reg, bf16x8& pa0, bf16x8& pa1, bf16x8& pa2, bf16x8& pa3) {
#pragma unroll
  for (int r = 0; r < 16; ++r) p1[r] = __builtin_amdgcn_exp2f(p1[r]);
  float ps = 0;
#pragma unroll
  for (int r = 0; r < 16; ++r) ps += p0[r];
#pragma unroll
  for (int r = 0; r < 16; ++r) ps += p1[r];
  { auto rr = __builtin_amdgcn_permlane32_swap(__float_as_uint(ps), __float_as_uint(ps), false, false);
    ps = __uint_as_float(rr[0]) + __uint_as_float(rr[1]); }
  l_reg = l_reg * alpha + ps;
#define PK4(P, BASE, OUT) do { unsigned a0 = cvt_pk_bf16(P[BASE + 0], P[BASE + 1]), a1 = cvt_pk_bf16(P[BASE + 2], P[BASE + 3]);   \
    unsigned b0 = cvt_pk_bf16(P[BASE + 4], P[BASE + 5]), b1 = cvt_pk_bf16(P[BASE + 6], P[BASE + 7]);                              \
    auto r0 = __builtin_amdgcn_permlane32_swap(a0, b0, false, false); auto r1 = __builtin_amdgcn_permlane32_swap(a1, b1, false, false); \
    u32x4 w = {r0[0], r1[0], r0[1], r1[1]}; OUT = *reinterpret_cast<bf16x8*>(&w); } while (0)
  PK4(p0, 0, pa0); PK4(p0, 8, pa1); PK4(p1, 0, pa2); PK4(p1, 8, pa3);
#undef PK4
}
template <int DQK, bool QRL = false>
__device__ __forceinline__ void qkt(f32x16& p0, f32x16& p1, const char* Ks, const char* K2s, const bf16x8* qr, int r32, int hi, const char* qrl = nullptr) {
  p0 = f32x16{}; p1 = f32x16{};
#pragma unroll
  for (int d0 = 0; d0 < 8; ++d0) { const int cb = (d0 * 16 + hi * 8) * 2;
    const bf16x8 b0 = *reinterpret_cast<const bf16x8*>(Ks + KSWZ(r32, cb));
    const bf16x8 b1 = *reinterpret_cast<const bf16x8*>(Ks + KSWZ(32 + r32, cb));
    p0 = __builtin_amdgcn_mfma_f32_32x32x16_bf16(b0, qr[d0], p0, 0, 0, 0);
    p1 = __builtin_amdgcn_mfma_f32_32x32x16_bf16(b1, qr[d0], p1, 0, 0, 0); }
  if constexpr (DQK == 192) {
#pragma unroll
    for (int d0 = 0; d0 < 4; ++d0) { const int cb = (d0 * 16 + hi * 8) * 2;
      const bf16x8 b0 = *reinterpret_cast<const bf16x8*>(K2s + KSWZ2(r32, cb));
      const bf16x8 b1 = *reinterpret_cast<const bf16x8*>(K2s + KSWZ2(32 + r32, cb));
      bf16x8 q; if constexpr (QRL) q = *reinterpret_cast<const bf16x8*>(qrl + d0 * 1024); else q = qr[8 + d0];
      p0 = __builtin_amdgcn_mfma_f32_32x32x16_bf16(b0, q, p0, 0, 0, 0);
      p1 = __builtin_amdgcn_mfma_f32_32x32x16_bf16(b1, q, p1, 0, 0, 0); }
  }
}
__device__ __forceinline__ int v_st(int k, int c) { const int kk = (k & ~0xC) | ((k & 4) << 1) | ((k & 8) >> 1); return ((kk >> 3) * 4 + (c >> 5)) * 512 + ((kk & 7) * 32 + (c & 31)) * 2; }
__device__ __forceinline__ int v_rd_base(int lane) { return ((lane & 3) << 3) | (((lane >> 2) & 3) << 6) | (((lane >> 4) & 1) << 5) | (((lane >> 5) & 1) << 8); }
constexpr int v_rd_off(int d0, int ks, int half) { return d0 * 512 + ks * 4096 + half * 2048; }
template <int OFF> __device__ __forceinline__ s16x4 tr_read(int vb) {
  s16x4 r; asm volatile("ds_read_b64_tr_b16 %0, %1 offset:%2" : "=&v"(r) : "v"(vb), "i"(OFF) : "memory"); return r;
}
template <int D0> __device__ __forceinline__ void pv_one(f32x16& od, int vb, bf16x8 pa0, bf16x8 pa1, bf16x8 pa2, bf16x8 pa3) {
  const s16x4 l0 = tr_read<v_rd_off(D0, 0, 0)>(vb), h0 = tr_read<v_rd_off(D0, 0, 1)>(vb), l1 = tr_read<v_rd_off(D0, 1, 0)>(vb), h1 = tr_read<v_rd_off(D0, 1, 1)>(vb);
  const s16x4 l2 = tr_read<v_rd_off(D0, 2, 0)>(vb), h2 = tr_read<v_rd_off(D0, 2, 1)>(vb), l3 = tr_read<v_rd_off(D0, 3, 0)>(vb), h3 = tr_read<v_rd_off(D0, 3, 1)>(vb);
  asm volatile("s_waitcnt lgkmcnt(0)" ::: "memory"); SBAR();
#define PK(L, H) (bf16x8){L[0], L[1], L[2], L[3], H[0], H[1], H[2], H[3]}
  od = __builtin_amdgcn_mfma_f32_32x32x16_bf16(pa0, PK(l0, h0), od, 0, 0, 0);
  od = __builtin_amdgcn_mfma_f32_32x32x16_bf16(pa1, PK(l1, h1), od, 0, 0, 0);
  od = __builtin_amdgcn_mfma_f32_32x32x16_bf16(pa2, PK(l2, h2), od, 0, 0, 0);
  od = __builtin_amdgcn_mfma_f32_32x32x16_bf16(pa3, PK(l3, h3), od, 0, 0, 0);
#undef PK
}
__device__ __forceinline__ void pv_d0(f32x16* o, int vb, bf16x8 pa0, bf16x8 pa1, bf16x8 pa2, bf16x8 pa3) {
  pv_one<0>(o[0], vb, pa0, pa1, pa2, pa3); pv_one<1>(o[1], vb, pa0, pa1, pa2, pa3); pv_one<2>(o[2], vb, pa0, pa1, pa2, pa3); pv_one<3>(o[3], vb, pa0, pa1, pa2, pa3);
}
template <int D0> __device__ __forceinline__ void pvT_one(f32x16& od, int vb, bf16x8 pa0, bf16x8 pa1, bf16x8 pa2, bf16x8 pa3) {
  const s16x4 l0 = tr_read<v_rd_off(D0, 0, 0)>(vb), h0 = tr_read<v_rd_off(D0, 0, 1)>(vb), l1 = tr_read<v_rd_off(D0, 1, 0)>(vb), h1 = tr_read<v_rd_off(D0, 1, 1)>(vb);
  const s16x4 l2 = tr_read<v_rd_off(D0, 2, 0)>(vb), h2 = tr_read<v_rd_off(D0, 2, 1)>(vb), l3 = tr_read<v_rd_off(D0, 3, 0)>(vb), h3 = tr_read<v_rd_off(D0, 3, 1)>(vb);
  asm volatile("s_waitcnt lgkmcnt(0)" ::: "memory"); SBAR();
#define PK(L, H) (bf16x8){L[0], L[1], L[2], L[3], H[0], H[1], H[2], H[3]}
  od = __builtin_amdgcn_mfma_f32_32x32x16_bf16(PK(l0, h0), pa0, od, 0, 0, 0);
  od = __builtin_amdgcn_mfma_f32_32x32x16_bf16(PK(l1, h1), pa1, od, 0, 0, 0);
  od = __builtin_amdgcn_mfma_f32_32x32x16_bf16(PK(l2, h2), pa2, od, 0, 0, 0);
  od = __builtin_amdgcn_mfma_f32_32x32x16_bf16(PK(l3, h3), pa3, od, 0, 0, 0);
#undef PK
}
__device__ __forceinline__ void pvT_d0(f32x16* o, int vb, bf16x8 pa0, bf16x8 pa1, bf16x8 pa2, bf16x8 pa3) {
  pvT_one<0>(o[0], vb, pa0, pa1, pa2, pa3); pvT_one<1>(o[1], vb, pa0, pa1, pa2, pa3); pvT_one<2>(o[2], vb, pa0, pa1, pa2, pa3); pvT_one<3>(o[3], vb, pa0, pa1, pa2, pa3);
}
template <int DQK, int SDEPTH, int LDQ, int LDK, int LDK2, int LDV, int LDO>
__device__ __forceinline__ void attn_body(const bf16_t* __restrict__ Qb, const bf16_t* __restrict__ Kh, const bf16_t* __restrict__ K2h, const bf16_t* __restrict__ Vh,
                                          bf16_t* __restrict__ Ob, int seq, const float scale, char* lds, const int wave, const float* __restrict__ ropec = nullptr, const float* __restrict__ ropes = nullptr) {
  const float C = scale * 1.4426950408889634f, thr_s = 8.f / scale;
  const int tid = launder_tid(wave), wid = wave, lane = tid & 63, r32 = lane & 31, hi = lane >> 5;
  char* V_lds = lds + OFF_V; char* K_lds = lds + OFF_K; char* K2_lds = lds + OFF_K2;
  const char* qrl = lds + OFF_QR + wid * 4096 + lane * 16;
  float m_reg = -1e30f, l_reg = 0; f32x16 o[4] = {}; bf16x8 qr[8];
  const bf16_t* Qw = Qb + (long)(wid * QBLK + r32) * LDQ + hi * 8;
#pragma unroll
  for (int d0 = 0; d0 < 8; ++d0) qr[d0] = *reinterpret_cast<const bf16x8*>(Qw + d0 * 16);
  if constexpr (DQK == 192) {
    const float* cp = ropec + (wid * QBLK + r32) * 32 + 8 * hi; const float* sp = ropes + (wid * QBLK + r32) * 32 + 8 * hi;
#pragma unroll
    for (int e = 0; e < 2; ++e) {
      const f32x4 c0 = *(const f32x4*)(cp + 16 * e), c1 = *(const f32x4*)(cp + 16 * e + 4), s0 = *(const f32x4*)(sp + 16 * e), s1 = *(const f32x4*)(sp + 16 * e + 4);
      const u32x4 a = *reinterpret_cast<const u32x4*>(Qw + (8 + e) * 16), b = *reinterpret_cast<const u32x4*>(Qw + (10 + e) * 16);
      const float x1[8] = {bf_lo(a.x), bf_hi(a.x), bf_lo(a.y), bf_hi(a.y), bf_lo(a.z), bf_hi(a.z), bf_lo(a.w), bf_hi(a.w)};
      const float x2[8] = {bf_lo(b.x), bf_hi(b.x), bf_lo(b.y), bf_hi(b.y), bf_lo(b.z), bf_hi(b.z), bf_lo(b.w), bf_hi(b.w)};
      const float cc[8] = {c0.x, c0.y, c0.z, c0.w, c1.x, c1.y, c1.z, c1.w}, sn[8] = {s0.x, s0.y, s0.z, s0.w, s1.x, s1.y, s1.z, s1.w};
      float y1[8], y2[8];
#pragma unroll
      for (int j = 0; j < 8; ++j) { y1[j] = x1[j] * cc[j] - x2[j] * sn[j]; y2[j] = x1[j] * sn[j] + x2[j] * cc[j]; }
      u32x4 oa, ob; oa.x = cvt_pk_bf16(y1[0], y1[1]); oa.y = cvt_pk_bf16(y1[2], y1[3]); oa.z = cvt_pk_bf16(y1[4], y1[5]); oa.w = cvt_pk_bf16(y1[6], y1[7]);
      ob.x = cvt_pk_bf16(y2[0], y2[1]); ob.y = cvt_pk_bf16(y2[2], y2[3]); ob.z = cvt_pk_bf16(y2[4], y2[5]); ob.w = cvt_pk_bf16(y2[6], y2[7]);
      *(u32x4*)(const_cast<char*>(qrl) + e * 1024) = oa; *(u32x4*)(const_cast<char*>(qrl) + (2 + e) * 1024) = ob;
    }
    asm volatile("s_waitcnt lgkmcnt(0)" ::: "memory");
  }
  const int sr = tid >> 4, sc = (tid & 15) * 8, vst0 = v_st(sr, sc), vst1 = v_st(32 + sr, sc);
  const int s2r = tid >> 3, s2c = (tid & 7) * 8;
  const int vb0 = (int)(uintptr_t)V_lds + v_rd_base(lane);
  struct { bf16x8 vs0, vs1, ks0, ks1, k2; } sr_[SDEPTH];
#define SLOAD(i, k0) do { sr_[i].vs0 = *reinterpret_cast<const bf16x8*>(&Vh[(long)((k0) + sr) * LDV + sc]); sr_[i].vs1 = *reinterpret_cast<const bf16x8*>(&Vh[(long)((k0) + 32 + sr) * LDV + sc]); \
    sr_[i].ks0 = *reinterpret_cast<const bf16x8*>(&Kh[(long)((k0) + sr) * LDK + sc]); sr_[i].ks1 = *reinterpret_cast<const bf16x8*>(&Kh[(long)((k0) + 32 + sr) * LDK + sc]); \
    if constexpr (DQK == 192) sr_[i].k2 = *reinterpret_cast<const bf16x8*>(&K2h[(long)((k0) + s2r) * LDK2 + s2c]); } while (0)
#define SWRITE(b, i) do { *(bf16x8*)(V_lds + (b) * SHM_V + vst0) = sr_[i].vs0; *(bf16x8*)(V_lds + (b) * SHM_V + vst1) = sr_[i].vs1; const int kc = sc * 2; \
    *(bf16x8*)(K_lds + (b) * SHM_K + KSWZ(sr, kc)) = sr_[i].ks0; *(bf16x8*)(K_lds + (b) * SHM_K + KSWZ(32 + sr, kc)) = sr_[i].ks1; \
    if constexpr (DQK == 192) *(bf16x8*)(K2_lds + (b) * SHM_K2 + KSWZ2(s2r, s2c * 2)) = sr_[i].k2; } while (0)
#define SWAIT() do { if constexpr (SDEPTH == 1) asm volatile("s_waitcnt vmcnt(0)" ::: "memory"); else if constexpr (DQK == 192) asm volatile("s_waitcnt vmcnt(5)" ::: "memory"); else asm volatile("s_waitcnt vmcnt(4)" ::: "memory"); } while (0)
#define RESC(a) do { if (__any((a) < 1.f)) { _Pragma("unroll") for (int d = 0; d < 4; ++d) _Pragma("unroll") for (int r = 0; r < 16; ++r) o[d][r] *= (a); } } while (0)
  f32x16 pA0, pA1, pB0, pB1; float mnA, mnB, alA, alB; bf16x8 pa0, pa1, pa2, pa3; const int NT = seq / KVBLK;
  constexpr int SE = 0, SO = SDEPTH - 1;
  SLOAD(SE, 0); asm volatile("s_waitcnt vmcnt(0)" ::: "memory"); SWRITE(0, SE); __syncthreads();
  qkt<DQK, true>(pA0, pA1, K_lds, K2_lds, qr, r32, hi, qrl); partialSM(pA0, pA1, m_reg, mnA, alA, C, thr_s);
  SLOAD(SO, KVBLK); if constexpr (SDEPTH == 2) { if (2 < NT) SLOAD(SE, 2 * KVBLK); }
  SWAIT(); SWRITE(1, SO); __syncthreads();
  for (int j = 1; j + 1 < NT; j += 2) {
    SBAR(); qkt<DQK, true>(pB0, pB1, K_lds + SHM_K, K2_lds + SHM_K2, qr, r32, hi, qrl);
    finishSM(pA0, pA1, alA, l_reg, pa0, pa1, pa2, pa3); SBAR();
    SLOAD(SO, (j + SDEPTH) * KVBLK); SBAR();
    pvT_d0(o, vb0, pa0, pa1, pa2, pa3); partialSM(pB0, pB1, m_reg, mnB, alB, C, thr_s);
    __syncthreads(); SWAIT(); SWRITE(0, SE);
    RESC(alB); __syncthreads();
    SBAR(); qkt<DQK, true>(pA0, pA1, K_lds, K2_lds, qr, r32, hi, qrl);
    finishSM(pB0, pB1, alB, l_reg, pa0, pa1, pa2, pa3); SBAR();
    if (SDEPTH == 1 || j + 3 < NT) SLOAD(SE, (j + 1 + SDEPTH) * KVBLK); SBAR();
    pvT_d0(o, vb0 + SHM_V, pa0, pa1, pa2, pa3); partialSM(pA0, pA1, m_reg, mnA, alA, C, thr_s);
    __syncthreads(); SWAIT(); SWRITE(1, SO);
    RESC(alA); __syncthreads();
  }
  SBAR(); qkt<DQK, true>(pB0, pB1, K_lds + SHM_K, K2_lds + SHM_K2, qr, r32, hi, qrl);
  finishSM(pA0, pA1, alA, l_reg, pa0, pa1, pa2, pa3); SBAR();
  pvT_d0(o, vb0, pa0, pa1, pa2, pa3); partialSM(pB0, pB1, m_reg, mnB, alB, C, thr_s);
  __syncthreads(); RESC(alB);
  finishSM(pB0, pB1, alB, l_reg, pa0, pa1, pa2, pa3); SBAR();
  pvT_d0(o, vb0 + SHM_V, pa0, pa1, pa2, pa3);
  { const float rl = __builtin_amdgcn_rcpf(l_reg);
    bf16_t* Ow = Ob + (long)(wid * QBLK + r32) * LDO + 4 * hi;
#pragma unroll
    for (int d0 = 0; d0 < 4; ++d0)
#pragma unroll
      for (int g = 0; g < 4; ++g) { u32x2 w; w.x = cvt_pk_bf16(o[d0][4 * g + 0] * rl, o[d0][4 * g + 1] * rl); w.y = cvt_pk_bf16(o[d0][4 * g + 2] * rl, o[d0][4 * g + 3] * rl);
        *(u32x2*)(Ow + d0 * 32 + 8 * g) = w; } }
  __syncthreads();
#undef SLOAD
#undef SWRITE
#undef SWAIT
#undef RESC
}

}

#define XB_TMO      128
#define XB_XCNT(j)  (256  + 64 * (j))
#define XB_XSUB(j)  (1280 + 64 * (j))
#define XB_XGEN(j)  (2304 + 64 * (j))
#define XB_TOP      3328
#define XB_TOPGEN   3392
#define XCD_BAR_WORDS 3456
#define XB_SPIN_CAP (1u << 18)
__device__ __forceinline__ unsigned xb_ld(unsigned* p)              { return __hip_atomic_load(p, __ATOMIC_RELAXED, __HIP_MEMORY_SCOPE_AGENT); }
__device__ __forceinline__ unsigned xb_add(unsigned* p, unsigned v) { return __hip_atomic_fetch_add(p, v, __ATOMIC_RELAXED, __HIP_MEMORY_SCOPE_AGENT); }
__device__ __forceinline__ unsigned xb_xcc_id() { return (unsigned)__builtin_amdgcn_s_getreg((3 << 11) | 20) & 0xFu; }
#define XB_SPIN(cond, bar) do { unsigned _sp = 0; while (cond) { __builtin_amdgcn_s_sleep(1); \
    if ((++_sp & 255u) == 0u) { if (xb_ld(&(bar)[XB_TMO])) break; if (_sp > XB_SPIN_CAP) { atomicAdd(&(bar)[XB_TMO], 1u); break; } } } } while (0)
struct XcdBarrier { unsigned* bar; unsigned x; volatile LAS unsigned* st; };
__device__ __forceinline__ XcdBarrier xcd_barrier_post(unsigned* bar, volatile LAS unsigned* st) {
    XcdBarrier b; b.bar = bar; b.x = xb_xcc_id(); b.st = st;
    if (threadIdx.x == 0) (void)xb_add(&bar[XB_XCNT(b.x)], 1u);
    return b;
}
__device__ __forceinline__ void xcd_barrier_complete(unsigned* bar, unsigned x, unsigned& nloc, unsigned& nx) {
    const unsigned G = gridDim.x * gridDim.y * gridDim.z;
    unsigned sum, cnt, mine, sp = 0u;
    for (;;) {
        sum = 0u; cnt = 0u; mine = 0u;
#pragma unroll
        for (unsigned j = 0; j < 16; ++j) { const unsigned c = xb_ld(&bar[XB_XCNT(j)]); sum += c; cnt += (c > 0u) ? 1u : 0u; mine = (j == x) ? c : mine; }
        if (sum == G) break;
        __builtin_amdgcn_s_sleep(1);
        if ((++sp & 255u) == 0u) { if (xb_ld(&bar[XB_TMO])) break; if (sp > XB_SPIN_CAP) { atomicAdd(&bar[XB_TMO], 1u); break; } }
    }
    nloc = mine > 0u ? mine : 1u; nx = cnt > 0u ? cnt : 1u;
}
__device__ __forceinline__ void xcd_barrier(const XcdBarrier& b) {
    asm volatile("s_waitcnt vmcnt(0)" ::: "memory");
    __syncthreads();
    if (threadIdx.x == 0) {
        unsigned* bar = b.bar;
        __builtin_amdgcn_s_waitcnt(0);
        unsigned nloc = b.st[0], nx = b.st[1];
        if (nloc == 0u) { xcd_barrier_complete(bar, b.x, nloc, nx); b.st[0] = nloc; b.st[1] = nx; }
        const unsigned old = xb_add(&bar[XB_XSUB(b.x)], 1u);
        const unsigned gen = old / nloc;
        if (old + 1u == (gen + 1u) * nloc) {
            __builtin_amdgcn_fence(__ATOMIC_RELEASE, "agent");
            asm volatile("s_waitcnt vmcnt(0)" ::: "memory");
            const unsigned og = xb_add(&bar[XB_TOP], 1u);
            const unsigned tg = og / nx;
            if (og + 1u == (tg + 1u) * nx) xb_add(&bar[XB_TOPGEN], 1u);
            else XB_SPIN(xb_ld(&bar[XB_TOPGEN]) == tg, bar);
            __builtin_amdgcn_fence(__ATOMIC_ACQUIRE, "agent");
            xb_add(&bar[XB_XGEN(b.x)], 1u);
            asm volatile("s_waitcnt vmcnt(0)" ::: "memory");
        } else {
            XB_SPIN(xb_ld(&bar[XB_XGEN(b.x)]) == gen, bar);
            __builtin_amdgcn_fence(__ATOMIC_ACQUIRE, "agent");
            asm volatile("s_waitcnt vmcnt(0)" ::: "memory");
        }
    }
    __syncthreads();
}

struct Args { const float* in[26]; float* out; unsigned char* ws; int ph_lo, ph_hi; };
enum { I_X = 0, I_C, I_CTX, I_CCTX, I_MODW, I_MODB, I_N1G, I_N2G, I_FING, I_WGU, I_WDOWN, I_EVIN, I_POOLW, I_POOLS, I_SGUNG, I_SGUWS, I_SGUB, I_EVOUT,
       I_ODIN, I_QAG, I_WQB, I_KVAG, I_WKVB, I_QNG, I_KNG, I_ODOUT };
constexpr int N_PHASES = 20;
constexpr int GQA_SDEPTH = 1, MLA_SDEPTH = 1;
constexpr int NH_P2 = 8, NH_P7 = 8, NH_P17 = 0;

__device__ __forceinline__ void conv_item(const float* __restrict__ W, int K, int N, bf16_t* __restrict__ WT, int map, int it, LAS unsigned char* tile, int lane) {
    const int nnb = N / 64;
    const int kq = lane >> 4, nq = lane & 15, rn = lane >> 3, ch = lane & 7;
    const int kc = it / nnb, nb = it - kc * nnb, n0 = nb * 64;
    int dr = n0;
    if (map == 1) { const int isu = n0 >= FFH, j = isu ? n0 - FFH : n0; dr = 256 * (j >> 7) + (isu ? 128 : 0) + (j & 127); }
    else if (map == 2) { dr = n0 < 3584 ? n0 : (n0 < 3648 ? OC_KR + (n0 - 3584) : n0 - 64); }
    const float* src = W + (size_t)(kc * 64 + 16 * kq) * N + n0 + 4 * nq;
    f32x4 v[16];
#pragma unroll
    for (int i = 0; i < 16; ++i) v[i] = __builtin_nontemporal_load((const f32x4*)(src + (size_t)i * N));
#pragma unroll
    for (int j = 0; j < 4; ++j) {
        u32x4 c0, c1;
        c0.x = cvt_pk_bf16(v[0][j], v[1][j]); c0.y = cvt_pk_bf16(v[2][j], v[3][j]); c0.z = cvt_pk_bf16(v[4][j], v[5][j]); c0.w = cvt_pk_bf16(v[6][j], v[7][j]);
        c1.x = cvt_pk_bf16(v[8][j], v[9][j]); c1.y = cvt_pk_bf16(v[10][j], v[11][j]); c1.z = cvt_pk_bf16(v[12][j], v[13][j]); c1.w = cvt_pk_bf16(v[14][j], v[15][j]);
        const int n = 4 * nq + j, sw = nq & 7;
        *(LAS u32x4*)(tile + n * 128 + (((2 * kq) ^ sw) << 4)) = c0; *(LAS u32x4*)(tile + n * 128 + (((2 * kq + 1) ^ sw) << 4)) = c1;
    }
    LDS_WAIT(); asm volatile("" ::: "memory");
    bf16_t* dst = WT + (size_t)dr * K + kc * 64 + 8 * ch;
#pragma unroll
    for (int t = 0; t < 8; ++t) { const int n = rn + 8 * t; const u32x4 o = *(const LAS u32x4*)(tile + n * 128 + ((ch ^ ((n >> 2) & 7)) << 4)); *(u32x4*)(dst + (size_t)n * K) = o; }
    LDS_WAIT(); asm volatile("" ::: "memory");
}
constexpr int CI_POOL = 0, CI_EVOUT = CI_POOL + 4 * 64, CI_GU0 = CI_EVOUT + 4096, CI_DOWN0 = CI_GU0 + 22016, CI_ODIN = CI_DOWN0 + 11008, CI_QB = CI_ODIN + 4672, CI_KVB = CI_QB + 768,
              CI_ODOUT = CI_KVB + 512, CI_GU1 = CI_ODOUT + 4096, CI_DOWN1 = CI_GU1 + 22016, CI_END = CI_DOWN1 + 11008;
constexpr int CV_P0A_LO = 0,        CV_P0A_HI = CI_DOWN0;
constexpr int CV_P2_LO = CI_DOWN0,  CV_P2_HI = CI_DOWN0 + 5500;
constexpr int CV_P7_LO = CV_P2_HI,  CV_P7_HI = CI_DOWN0 + 26500;
constexpr int CV_P0B_LO = CI_END,  CV_P0B_HI = CI_END;
constexpr int CV_OPT_LO = CV_P7_HI, CV_OPT_HI = CI_END;
constexpr int CV_P17_LO = CI_END, CV_P17_HI = CI_END;
struct ConvCtx { const float* pool; const float* evout; const float* gu; const float* down; const float* odin; const float* qb; const float* kvb; const float* odout; unsigned char* ws; };
__device__ __forceinline__ void conv_list_item(const ConvCtx& c, int it, LAS unsigned char* tile, int lane) {
    if (it < CI_EVOUT) { const int g = it >> 6; conv_item(c.pool + (size_t)g * 512 * 512, 512, 512, (bf16_t*)(c.ws + WS_WPOOL) + (size_t)g * 512 * 512, 0, it & 63, tile, lane); }
    else if (it < CI_GU0) conv_item(c.evout, D, D, (bf16_t*)(c.ws + WS_WEVOUT), 0, it - CI_EVOUT, tile, lane);
    else if (it < CI_DOWN0) conv_item(c.gu, D, FFN2, (bf16_t*)(c.ws + WS_WGU), 1, it - CI_GU0, tile, lane);
    else if (it < CI_ODIN) conv_item(c.down, FFH, D, (bf16_t*)(c.ws + WS_WDOWN), 0, it - CI_DOWN0, tile, lane);
    else if (it < CI_QB) conv_item(c.odin, D, ODIN, (bf16_t*)(c.ws + WS_WODIN), 2, it - CI_ODIN, tile, lane);
    else if (it < CI_KVB) conv_item(c.qb, 1024, QMW, (bf16_t*)(c.ws + WS_WQB), 0, it - CI_QB, tile, lane);
    else if (it < CI_ODOUT) conv_item(c.kvb, 512, KVW, (bf16_t*)(c.ws + WS_WKVB), 0, it - CI_KVB, tile, lane);
    else if (it < CI_GU1) conv_item(c.odout, D, D, (bf16_t*)(c.ws + WS_WODOUT), 0, it - CI_ODOUT, tile, lane);
    else if (it < CI_DOWN1) conv_item(c.gu + (size_t)D * FFN2, D, FFN2, (bf16_t*)(c.ws + WS_WGU + WGU_L), 1, it - CI_GU1, tile, lane);
    else conv_item(c.down + (size_t)FFH * D, FFH, D, (bf16_t*)(c.ws + WS_WDOWN + WDOWN_L), 0, it - CI_DOWN1, tile, lane);
}
__device__ __forceinline__ void conv_desc(const ConvCtx& c, int it, int lane, const float*& src, int& N, bf16_t*& dst, int& K) {
    const float* W; bf16_t* WT; int map = 0, li;
    if (it < CI_EVOUT) { const int g = it >> 6; W = c.pool + (size_t)g * 512 * 512; K = 512; N = 512; WT = (bf16_t*)(c.ws + WS_WPOOL) + (size_t)g * 512 * 512; li = it & 63; }
    else if (it < CI_GU0) { W = c.evout; K = D; N = D; WT = (bf16_t*)(c.ws + WS_WEVOUT); li = it - CI_EVOUT; }
    else if (it < CI_DOWN0) { W = c.gu; K = D; N = FFN2; WT = (bf16_t*)(c.ws + WS_WGU); map = 1; li = it - CI_GU0; }
    else if (it < CI_ODIN) { W = c.down; K = FFH; N = D; WT = (bf16_t*)(c.ws + WS_WDOWN); li = it - CI_DOWN0; }
    else if (it < CI_QB) { W = c.odin; K = D; N = ODIN; WT = (bf16_t*)(c.ws + WS_WODIN); map = 2; li = it - CI_ODIN; }
    else if (it < CI_KVB) { W = c.qb; K = 1024; N = QMW; WT = (bf16_t*)(c.ws + WS_WQB); li = it - CI_QB; }
    else if (it < CI_ODOUT) { W = c.kvb; K = 512; N = KVW; WT = (bf16_t*)(c.ws + WS_WKVB); li = it - CI_KVB; }
    else if (it < CI_GU1) { W = c.odout; K = D; N = D; WT = (bf16_t*)(c.ws + WS_WODOUT); li = it - CI_ODOUT; }
    else if (it < CI_DOWN1) { W = c.gu + (size_t)D * FFN2; K = D; N = FFN2; WT = (bf16_t*)(c.ws + WS_WGU + WGU_L); map = 1; li = it - CI_GU1; }
    else { W = c.down + (size_t)FFH * D; K = FFH; N = D; WT = (bf16_t*)(c.ws + WS_WDOWN + WDOWN_L); li = it - CI_DOWN1; }
    const int nnb = N / 64, kq = lane >> 4, nq = lane & 15, ch = lane & 7;
    const int kc = li / nnb, nb = li - kc * nnb, n0 = nb * 64;
    int dr = n0;
    if (map == 1) { const int isu = n0 >= FFH, j = isu ? n0 - FFH : n0; dr = 256 * (j >> 7) + (isu ? 128 : 0) + (j & 127); }
    else if (map == 2) { dr = n0 < 3584 ? n0 : (n0 < 3648 ? OC_KR + (n0 - 3584) : n0 - 64); }
    src = W + (size_t)(kc * 64 + 16 * kq) * N + n0 + 4 * nq;
    dst = WT + (size_t)dr * K + kc * 64 + 8 * ch;
}
template <bool ADAPT = false>
__device__ __forceinline__ void conv_range(const ConvCtx& c, int lo, int hi, int hw, int nh, int wave, LAS unsigned char* L, unsigned* done_cnt = nullptr, unsigned done_need = 0u, int* stop_slot = nullptr) {
    const int lane = launder_tid(wave) & 63; LAS unsigned char* tile = L + wave * 8192;
    const int kq = lane >> 4, nq = lane & 15, rn = lane >> 3, ch = lane & 7, sw = nq & 7, stride = nh * 8;
    int it = lo + hw * 8 + wave; if (it >= hi) { if (ADAPT && lane == 0) __hip_atomic_store(stop_slot, hi, __ATOMIC_RELAXED, __HIP_MEMORY_SCOPE_AGENT); return; }
    const float* src; bf16_t* dst; int N, K; f32x4 v[16];
    conv_desc(c, it, lane, src, N, dst, K);
#pragma unroll
    for (int i = 0; i < 16; ++i) v[i] = __builtin_nontemporal_load((const f32x4*)(src + (size_t)i * N));
    for (;;) {
        const int nx = it + stride; const bool more = nx < hi;
        unsigned dn = 0u; if (ADAPT) dn = __hip_atomic_load(done_cnt, __ATOMIC_RELAXED, __HIP_MEMORY_SCOPE_AGENT);
        const float* src2 = src; bf16_t* dst2 = dst; int N2 = N, K2 = K; f32x4 w[16];
        if (more) { conv_desc(c, nx, lane, src2, N2, dst2, K2);
#pragma unroll
            for (int i = 0; i < 16; ++i) w[i] = __builtin_nontemporal_load((const f32x4*)(src2 + (size_t)i * N2)); }
#pragma unroll
        for (int j = 0; j < 4; ++j) {
            u32x4 c0, c1;
            c0.x = cvt_pk_bf16(v[0][j], v[1][j]); c0.y = cvt_pk_bf16(v[2][j], v[3][j]); c0.z = cvt_pk_bf16(v[4][j], v[5][j]); c0.w = cvt_pk_bf16(v[6][j], v[7][j]);
            c1.x = cvt_pk_bf16(v[8][j], v[9][j]); c1.y = cvt_pk_bf16(v[10][j], v[11][j]); c1.z = cvt_pk_bf16(v[12][j], v[13][j]); c1.w = cvt_pk_bf16(v[14][j], v[15][j]);
            const int n = 4 * nq + j;
            *(LAS u32x4*)(tile + n * 128 + (((2 * kq) ^ sw) << 4)) = c0; *(LAS u32x4*)(tile + n * 128 + (((2 * kq + 1) ^ sw) << 4)) = c1;
        }
        LDS_WAIT(); asm volatile("" ::: "memory");
#pragma unroll
        for (int t = 0; t < 8; ++t) { const int n = rn + 8 * t; const u32x4 o = *(const LAS u32x4*)(tile + n * 128 + ((ch ^ ((n >> 2) & 7)) << 4)); *(u32x4*)(dst + (size_t)n * K) = o; }
        LDS_WAIT(); asm volatile("" ::: "memory");
        if (!more) { if (ADAPT && lane == 0) __hip_atomic_store(stop_slot, hi, __ATOMIC_RELAXED, __HIP_MEMORY_SCOPE_AGENT); break; }
        if (ADAPT && (unsigned)__builtin_amdgcn_readfirstlane((int)dn) >= done_need) { if (lane == 0) __hip_atomic_store(stop_slot, nx, __ATOMIC_RELAXED, __HIP_MEMORY_SCOPE_AGENT); break; }
#pragma unroll
        for (int i = 0; i < 16; ++i) v[i] = w[i];
        it = nx; src = src2; dst = dst2; N = N2; K = K2;
    }
}

__device__ __forceinline__ void conv_catchup(const ConvCtx& c, int hi, int nslots, const int* stop, int gw, int ngw, int wave, LAS unsigned char* L) {
    const int lane = launder_tid(wave) & 63; LAS unsigned char* tile = L + wave * 8192;
    const int k = gw % nslots, j = gw / nslots, nj = ngw / nslots;
    for (int it = __builtin_amdgcn_readfirstlane(__hip_atomic_load(stop + k, __ATOMIC_RELAXED, __HIP_MEMORY_SCOPE_AGENT)) + j * nslots; it < hi; it += nj * nslots) conv_list_item(c, it, tile, lane);
}

template <int W>
__device__ __forceinline__ void pool_run(const bf16_t* __restrict__ Z, bf16_t* __restrict__ PA, int seg0, int segl, int t0, int g, int lane) {
    constexpr int HW = W / 2, NR = 8 + W - 1;
    const bf16_t* zc = Z + (size_t)seg0 * EV_IN + g * 512 + lane * 8;
    u32x4 rb[NR];
#pragma unroll
    for (int i = 0; i < NR; ++i) { int rr = t0 - HW + i; rr = min(max(rr, 0), segl - 1); rb[i] = *(const u32x4*)(zc + (size_t)rr * EV_IN); }
#pragma unroll
    for (int o = 0; o < 8; ++o) { const int t = t0 + o;
        float s[8];
#pragma unroll
        for (int e = 0; e < 8; ++e) s[e] = 0.f;
#pragma unroll
        for (int k = 0; k < W; ++k) { const int rr = t - HW + k; const float wgt = (rr >= 0 && rr < segl) ? 1.f : 0.f; const u32x4 q = rb[o + k];
            s[0] = fmaf(wgt, bf_lo(q.x), s[0]); s[1] = fmaf(wgt, bf_hi(q.x), s[1]); s[2] = fmaf(wgt, bf_lo(q.y), s[2]); s[3] = fmaf(wgt, bf_hi(q.y), s[3]);
            s[4] = fmaf(wgt, bf_lo(q.z), s[4]); s[5] = fmaf(wgt, bf_hi(q.z), s[5]); s[6] = fmaf(wgt, bf_lo(q.w), s[6]); s[7] = fmaf(wgt, bf_hi(q.w), s[7]); }
        const int wlo = max(t - HW, 0), whi = min(t - HW + W, segl); const float inv = 1.0f / (float)(whi - wlo);
        const u32x4 q = rb[o + HW];
        u32x4 r; r.x = cvt_pk_bf16(s[0] * inv - bf_lo(q.x), s[1] * inv - bf_hi(q.x)); r.y = cvt_pk_bf16(s[2] * inv - bf_lo(q.y), s[3] * inv - bf_hi(q.y));
        r.z = cvt_pk_bf16(s[4] * inv - bf_lo(q.z), s[5] * inv - bf_hi(q.z)); r.w = cvt_pk_bf16(s[6] * inv - bf_lo(q.w), s[7] * inv - bf_hi(q.w));
        *(u32x4*)(PA + (size_t)(seg0 + t) * 2048 + g * 512 + lane * 8) = r; }
}

__device__ __forceinline__ void norm_coop_x(const bf16_t* __restrict__ XB, bf16_t* __restrict__ H, const float* __restrict__ gvec, const float* __restrict__ modl  ,
                                            int wg, int nwg, int wave, LAS float* red) {
    const int lane = launder_tid(wave) & 63, c = 512 * wave + 8 * lane;
    for (int chunk = wg; chunk < NB * SEQ / 64; chunk += nwg) {
        const int b = chunk >> 5;
        const float* shp = modl + (size_t)b * MODW + c; const float* scp = shp + D;
        float A[8], Bc[8];
        { const f32x4 g0 = *(const f32x4*)(gvec + c), g1 = *(const f32x4*)(gvec + c + 4), s10 = *(const f32x4*)scp, s11 = *(const f32x4*)(scp + 4), s00 = *(const f32x4*)shp, s01 = *(const f32x4*)(shp + 4);
#pragma unroll
          for (int e = 0; e < 4; ++e) { A[e] = g0[e] * (s10[e] + 1.0f); A[4 + e] = g1[e] * (s11[e] + 1.0f); Bc[e] = s00[e]; Bc[4 + e] = s01[e]; } }
        const size_t row0 = (size_t)xrow(chunk * 64);
#pragma unroll 1
        for (int g = 0; g < 4; ++g) {
            const bf16_t* src = XB + (row0 + g * 16) * D + c;
            u32x4 v[16]; float ps[16];
#pragma unroll
            for (int r = 0; r < 16; ++r) v[r] = *(const u32x4*)(src + (size_t)r * D);
#pragma unroll
            for (int r = 0; r < 16; ++r) { const float a0 = bf_lo(v[r].x), a1 = bf_hi(v[r].x), a2 = bf_lo(v[r].y), a3 = bf_hi(v[r].y), a4 = bf_lo(v[r].z), a5 = bf_hi(v[r].z), a6 = bf_lo(v[r].w), a7 = bf_hi(v[r].w);
                ps[r] = wave_sum((a0 * a0 + a1 * a1) + (a2 * a2 + a3 * a3) + (a4 * a4 + a5 * a5) + (a6 * a6 + a7 * a7)); }
            LAS float* rb = red + (g & 1) * 128;
            if (lane < 16) { float mine = ps[0];
#pragma unroll
                for (int r = 1; r < 16; ++r) mine = (lane == r) ? ps[r] : mine;
                rb[lane * 8 + wave] = mine; }
            LDS_WAIT(); __syncthreads();
            bf16_t* dst = H + (row0 + g * 16) * D + c;
#pragma unroll
            for (int r = 0; r < 16; ++r) { const f32x4 t0 = *(const LAS f32x4*)(rb + r * 8), t1 = *(const LAS f32x4*)(rb + r * 8 + 4);
                const float tot = ((t0[0] + t0[1]) + (t0[2] + t0[3])) + ((t1[0] + t1[1]) + (t1[2] + t1[3]));
                const float rstd = 1.0f / sqrtf(tot * (1.0f / D) + EPS);
                const float x0 = bf_lo(v[r].x), x1 = bf_hi(v[r].x), x2 = bf_lo(v[r].y), x3 = bf_hi(v[r].y), x4 = bf_lo(v[r].z), x5 = bf_hi(v[r].z), x6 = bf_lo(v[r].w), x7 = bf_hi(v[r].w);
                u32x4 w; w.x = cvt_pk_bf16(x0 * rstd * A[0] + Bc[0], x1 * rstd * A[1] + Bc[1]); w.y = cvt_pk_bf16(x2 * rstd * A[2] + Bc[2], x3 * rstd * A[3] + Bc[3]);
                w.z = cvt_pk_bf16(x4 * rstd * A[4] + Bc[4], x5 * rstd * A[5] + Bc[5]); w.w = cvt_pk_bf16(x6 * rstd * A[6] + Bc[6], x7 * rstd * A[7] + Bc[7]);
                *(u32x4*)(dst + (size_t)r * D) = w; }
        }
        __syncthreads();
    }
}

__global__ void __launch_bounds__(512, 2) trunk_fwd(Args args) {
    extern __shared__ __attribute__((aligned(16))) unsigned char lds[];
    LAS unsigned char* L = (LAS unsigned char*)lds;
    volatile LAS unsigned* MISC = (volatile LAS unsigned*)(L + MISC_OFF);
    const int wave = __builtin_amdgcn_readfirstlane((int)threadIdx.x >> 6);
    const int G = gridDim.x, bx = blockIdx.x, vcu = (G % 8 == 0) ? (bx % 8) * (G / 8) + bx / 8 : bx;
    const int gw = vcu * 8 + wave, NGW = G * 8;
    unsigned char* ws = args.ws;
    unsigned* ctl = (unsigned*)(ws + WS_CTL);
    float* MOD = (float*)(ws + WS_MOD);
    float* ROPEM = (float*)(ws + WS_ROPEM); float* ROPEG = (float*)(ws + WS_ROPEG);
    bf16_t* W_EVIN = (bf16_t*)(ws + WS_WEVIN); bf16_t* W_EVOUT = (bf16_t*)(ws + WS_WEVOUT); bf16_t* W_POOL = (bf16_t*)(ws + WS_WPOOL); bf16_t* W_SGU = (bf16_t*)(ws + WS_WSGU);
    bf16_t* W_ODIN = (bf16_t*)(ws + WS_WODIN); bf16_t* W_QB = (bf16_t*)(ws + WS_WQB); bf16_t* W_KVB = (bf16_t*)(ws + WS_WKVB); bf16_t* W_ODOUT = (bf16_t*)(ws + WS_WODOUT);
    float* X = (float*)(ws + WS_X); bf16_t* H = (bf16_t*)(ws + WS_H); bf16_t* Z = (bf16_t*)(ws + WS_Z); bf16_t* PA = (bf16_t*)(ws + WS_PA); bf16_t* YC = (bf16_t*)(ws + WS_YC);
    bf16_t* XB = (bf16_t*)(ws + WS_XB); float* PART = (float*)(ws + WS_PART); bf16_t* HID = (bf16_t*)(ws + WS_HID); bf16_t* QM = (bf16_t*)(ws + WS_QM); bf16_t* KVM = (bf16_t*)(ws + WS_KVM);

    const ConvCtx cc{args.in[I_POOLW], args.in[I_EVOUT], args.in[I_WGU], args.in[I_WDOWN], args.in[I_ODIN], args.in[I_WQB], args.in[I_WKVB], args.in[I_ODOUT], ws};
    for (int u = threadIdx.x; u < (LDS_BYTES - RING_BYTES) / 4; u += 512) ((LAS unsigned*)(L + RING_BYTES))[u] = 0u;
    __syncthreads();
#if MK_N_LAUNCHES == 1
    XcdBarrier bar = xcd_barrier_post(ctl + CW_BAR, MISC + 8);
#define GRID_BAR() xcd_barrier(bar)
#else
#define GRID_BAR() do {} while (0)
#endif
    const int lo = args.ph_lo, hi = args.ph_hi;
#define IN(k) (lo <= (k) && (k) < hi)
#define SEAM(k) do { if (IN(k) && IN((k) + 1)) GRID_BAR(); } while (0)

    if (IN(0)) { const int tid = launder_tid(wave), lane = tid & 63; (void)tid; (void)lane;
        for (int s01 = 0; s01 < 2; ++s01) {
        if ((s01 == 0) == (((bx >> 3) & 1) == 0)) {
            LAS float* red = (LAS float*)L;
            for (int item = vcu; item < 256; item += G) {
                const int layer = item >> 7, cb = item & 127, col0 = cb * 192 + 3 * lane;
                const float* Wl = args.in[I_MODW] + (size_t)layer * D * MODW;
                float acc[9][3];
#pragma unroll
                for (int r = 0; r < 9; ++r) { acc[r][0] = 0.f; acc[r][1] = 0.f; acc[r][2] = 0.f; }
                for (int ch = 0; ch < 8; ++ch) {
                    const int k0 = wave * 512 + ch * 64;
                    float sv[9];
#pragma unroll
                    for (int r = 0; r < 9; ++r) { const float cv = (r < 8) ? args.in[I_C][r * D + k0 + lane] : args.in[I_CCTX][k0 + lane]; sv[r] = cv / (1.0f + expf(-cv)); }
                    const float* wp = Wl + (size_t)k0 * MODW + col0;
#pragma unroll 16
                    for (int kk = 0; kk < 64; ++kk) {
                        const float w0 = __builtin_nontemporal_load(wp + (size_t)kk * MODW), w1 = __builtin_nontemporal_load(wp + (size_t)kk * MODW + 1), w2 = __builtin_nontemporal_load(wp + (size_t)kk * MODW + 2);
#pragma unroll
                        for (int r = 0; r < 9; ++r) { const float s = __builtin_bit_cast(float, __builtin_amdgcn_readlane(__builtin_bit_cast(int, sv[r]), kk)); acc[r][0] = fmaf(s, w0, acc[r][0]); acc[r][1] = fmaf(s, w1, acc[r][1]); acc[r][2] = fmaf(s, w2, acc[r][2]); }
                    }
                }
#pragma unroll
                for (int r = 0; r < 9; ++r)
#pragma unroll
                    for (int e = 0; e < 3; ++e) red[(wave * 27 + r * 3 + e) * 64 + lane] = acc[r][e];
                __syncthreads();
                for (int o = tid; o < 27 * 64; o += 512) {
                    float s = 0.f;
#pragma unroll
                    for (int w = 0; w < 8; ++w) s += red[w * 27 * 64 + o];
                    const int j = o >> 6, ln = o & 63, r = j / 3, e = j % 3, col = cb * 192 + 3 * ln + e;
                    MOD[((size_t)layer * 9 + r) * MODW + col] = s + args.in[I_MODB][layer * MODW + col];
                }
                __syncthreads();
            }
        } else {
          LAS unsigned char* tile = L + wave * 8192;
          for (int it = gw; it < (D / 64) * (EV_IN / 64); it += NGW) conv_item(args.in[I_EVIN], D, EV_IN, W_EVIN, 0, it, tile, lane);
          for (int it = CV_P0A_LO + gw; it < CV_P0A_HI; it += NGW) conv_list_item(cc, it, tile, lane);
          for (int it = CV_P0B_LO + gw; it < CV_P0B_HI; it += NGW) conv_list_item(cc, it, tile, lane);
          __syncthreads();
        } }
        for (int i = gw * 64 + lane; i < 2048 * 96; i += NGW * 64) {
            const int t = i / 96, f = i % 96; const float row = (float)(t >> 6), colp = (float)(t & 63);
            if (f < 32) { const int ff = f & 15; const float inv = powf(10000.0f, -(float)ff / 16.0f); const float ang = (f < 16 ? row : colp) * inv; ROPEM[t * 32 + f] = cosf(ang); ROPEM[2048 * 32 + t * 32 + f] = sinf(ang); }
            else { const int f2 = f - 32, ff = f2 & 31; const float inv = powf(10000.0f, -(float)ff / 32.0f); const float ang = (f2 < 32 ? row : colp) * inv; ROPEG[t * 64 + f2] = cosf(ang); ROPEG[2048 * 64 + t * 64 + f2] = sinf(ang); }
        }
        for (int i = gw * 64 + lane; i < 4 * 128 * 128; i += NGW * 64) W_SGU[i] = f2bf(args.in[I_SGUWS][i]);
        for (int i = gw * 64 + lane; i < (ODIN_P - ODIN) * D / 8; i += NGW * 64) *(u32x4*)(W_ODIN + (size_t)ODIN * D + (size_t)i * 8) = (u32x4){0u, 0u, 0u, 0u};
    }
    SEAM(0);

#define NORM_PHASE(LAYER, WHICH, FROM_INPUT, XONLY) do { \
        const float* gvec = args.in[(WHICH) == 0 ? I_N1G : I_N2G] + (LAYER) * D; \
        const int nrows = (XONLY) ? NB * SEQ : MALL; \
        for (int idx = gw; idx < nrows; idx += NGW) { \
            const int R = (XONLY) ? xrow(idx) : idx; const int b = R / LT, j = R % LT; const int mr = j < CTXL ? 8 : b; \
            const float* srow = (FROM_INPUT) ? (j < CTXL ? args.in[I_CTX] + ((size_t)b * CTXL + j) * D : args.in[I_X] + ((size_t)b * SEQ + (j - CTXL)) * D) : X + (size_t)R * D; \
            const float* shp = MOD + ((size_t)(LAYER) * 9 + mr) * MODW + (WHICH) * 3 * D; const float* scp = shp + D; \
            f32x4 v[16]; float ss = 0.f; \
            _Pragma("unroll") for (int q = 0; q < 16; ++q) { v[q] = *(const f32x4*)(srow + (q * 64 + lane) * 4); ss += (v[q].x * v[q].x + v[q].y * v[q].y) + (v[q].z * v[q].z + v[q].w * v[q].w); } \
            const float rstd = 1.0f / sqrtf(wave_sum(ss) * (1.0f / D) + EPS); \
            bf16_t* hrow = H + (size_t)R * D; \
            _Pragma("unroll") for (int q = 0; q < 16; ++q) { const int c = (q * 64 + lane) * 4; const f32x4 gg = *(const f32x4*)(gvec + c), s1 = *(const f32x4*)(scp + c), s0 = *(const f32x4*)(shp + c); \
                const f32x4 y = v[q] * rstd * gg * (s1 + 1.0f) + s0; u32x2 w; w.x = cvt_pk_bf16(y.x, y.y); w.y = cvt_pk_bf16(y.z, y.w); *(u32x2*)(hrow + c) = w; } \
        } } while (0)

#define NORM_PHASE_B(LAYER, WHICH, XONLY) do { \
        const float* gvec = args.in[(WHICH) == 0 ? I_N1G : I_N2G] + (LAYER) * D; \
        const int nrows = (XONLY) ? NB * SEQ : MALL; \
        for (int idx = gw; idx < nrows; idx += NGW) { \
            const int R = (XONLY) ? xrow(idx) : idx; const int b = R / LT, j = R % LT; const int mr = j < CTXL ? 8 : b; \
            const bf16_t* srow = XB + (size_t)R * D; \
            const float* shp = MOD + ((size_t)(LAYER) * 9 + mr) * MODW + (WHICH) * 3 * D; const float* scp = shp + D; \
            u32x4 v[8]; float ss = 0.f; \
            _Pragma("unroll") for (int q = 0; q < 8; ++q) { v[q] = *(const u32x4*)(srow + (q * 64 + lane) * 8); \
                const float a0 = bf_lo(v[q].x), a1 = bf_hi(v[q].x), a2 = bf_lo(v[q].y), a3 = bf_hi(v[q].y), a4 = bf_lo(v[q].z), a5 = bf_hi(v[q].z), a6 = bf_lo(v[q].w), a7 = bf_hi(v[q].w); \
                ss += (a0 * a0 + a1 * a1) + (a2 * a2 + a3 * a3) + (a4 * a4 + a5 * a5) + (a6 * a6 + a7 * a7); } \
            const float rstd = 1.0f / sqrtf(wave_sum(ss) * (1.0f / D) + EPS); \
            bf16_t* hrow = H + (size_t)R * D; \
            _Pragma("unroll") for (int q = 0; q < 8; ++q) { const int c = (q * 64 + lane) * 8; \
                const f32x4 g0 = *(const f32x4*)(gvec + c), g1 = *(const f32x4*)(gvec + c + 4), s10 = *(const f32x4*)(scp + c), s11 = *(const f32x4*)(scp + c + 4), s00 = *(const f32x4*)(shp + c), s01 = *(const f32x4*)(shp + c + 4); \
                const f32x4 x0 = (f32x4){bf_lo(v[q].x), bf_hi(v[q].x), bf_lo(v[q].y), bf_hi(v[q].y)}, x1 = (f32x4){bf_lo(v[q].z), bf_hi(v[q].z), bf_lo(v[q].w), bf_hi(v[q].w)}; \
                const f32x4 y0 = x0 * rstd * g0 * (s10 + 1.0f) + s00, y1 = x1 * rstd * g1 * (s11 + 1.0f) + s01; \
                u32x4 w; w.x = cvt_pk_bf16(y0.x, y0.y); w.y = cvt_pk_bf16(y0.z, y0.w); w.z = cvt_pk_bf16(y1.x, y1.y); w.w = cvt_pk_bf16(y1.z, y1.w); *(u32x4*)(hrow + c) = w; } \
        } } while (0)

#define NORM_CTX_COMBINE(LAYER, WHICH, FROM_INPUT, GATEP, STORE_X) do { \
        const float* gvec = args.in[(WHICH) == 0 ? I_N1G : I_N2G] + (LAYER) * D; \
        const float* shp = MOD + ((size_t)(LAYER) * 9 + 8) * MODW + (WHICH) * 3 * D; const float* scp = shp + D; \
        for (int cr = gw; cr < NB * CTXL; cr += NGW) { \
            const int b = cr >> 8, j = cr & 255; const size_t R = (size_t)b * LT + j; \
            const float* srow = (FROM_INPUT) ? args.in[I_CTX] + (size_t)cr * D : X + R * D; \
            const float* p0 = PART + (size_t)cr * D; const float* p1 = p0 + (size_t)NB * CTXL * D; \
            f32x4 v[16]; float ss = 0.f; \
            _Pragma("unroll") for (int q = 0; q < 16; ++q) { const int c = (q * 64 + lane) * 4; \
                v[q] = *(const f32x4*)(srow + c) + *(const f32x4*)((GATEP) + c) * (*(const f32x4*)(p0 + c) + *(const f32x4*)(p1 + c)); \
                if (STORE_X) *(f32x4*)(X + R * D + c) = v[q]; \
                ss += (v[q].x * v[q].x + v[q].y * v[q].y) + (v[q].z * v[q].z + v[q].w * v[q].w); \
                if ((q & 3) == 3) asm volatile("" ::: "memory"); } \
            const float rstd = 1.0f / sqrtf(wave_sum(ss) * (1.0f / D) + EPS); \
            bf16_t* hrow = H + R * D; \
            _Pragma("unroll") for (int q = 0; q < 16; ++q) { const int c = (q * 64 + lane) * 4; const f32x4 gg = *(const f32x4*)(gvec + c), s1 = *(const f32x4*)(scp + c), s0 = *(const f32x4*)(shp + c); \
                const f32x4 y = v[q] * rstd * gg * (s1 + 1.0f) + s0; u32x2 w; w.x = cvt_pk_bf16(y.x, y.y); w.y = cvt_pk_bf16(y.z, y.w); *(u32x2*)(hrow + c) = w; } \
        } } while (0)

    if (IN(1)) { const int tid = launder_tid(wave), lane = tid & 63; (void)tid; (void)lane; NORM_PHASE(0, 0, true, false); }
    SEAM(1);

    if (IN(2)) {
        if (bx < G - NH_P2) { pg8::Gemm g{H, W_EVIN, D, D, D, 30, 0}; pg8::OrderAll S{EV_IN / 256, G - NH_P2, bx}; pg8::EpiBf16 E{Z, EV_IN, 8};
            pg8::gemm_phase(L, g, S, E, wave); }
        else conv_range(cc, CV_P2_LO, CV_P2_HI, bx - (G - NH_P2), NH_P2, wave, L);
    }
    SEAM(2);

    if (IN(3)) { const int tid = launder_tid(wave), lane = tid & 63; (void)tid; (void)lane;
        {
            constexpr int nitems = (MALL / 8) * 4; const int nheavy = (G >= 128 ? 64 : 0) * 8, nlight = NGW - nheavy, rest = nitems - 2 * nheavy;
            const int it_lo = gw < nheavy ? 2 * gw : 2 * nheavy + (int)((long)(gw - nheavy) * rest / nlight), it_hi = gw < nheavy ? 2 * gw + 2 : 2 * nheavy + (int)((long)(gw - nheavy + 1) * rest / nlight);
            for (int it = it_lo; it < it_hi; ++it) {
                const int g = it & 3, R0 = (it >> 2) * 8;
                const int b = R0 / LT, j = R0 % LT; const int seg0 = j < CTXL ? b * LT : b * LT + CTXL, segl = j < CTXL ? CTXL : SEQ, t0 = R0 - seg0;
                if (g == 0) pool_run<2>(Z, PA, seg0, segl, t0, 0, lane); else if (g == 1) pool_run<4>(Z, PA, seg0, segl, t0, 1, lane);
                else if (g == 2) pool_run<8>(Z, PA, seg0, segl, t0, 2, lane); else pool_run<16>(Z, PA, seg0, segl, t0, 3, lane);
            }
        }
        {
            const int wp = wave & 3, wd = wave >> 2, r32 = lane & 31, hl = lane >> 5;
            for (int un = vcu; un < (MALL / 128) * 4; un += G) {
                const int ch = un >> 2, h = un & 3, R0 = ch * 128;
                bf16x8 pa[8];
                { const bf16_t* wsp = W_SGU + ((size_t)h * 128 + 32 * wp + r32) * 128 + 8 * hl;
#pragma unroll
                  for (int ks = 0; ks < 8; ++ks) pa[ks] = *(const bf16x8*)(wsp + 16 * ks); }
                { const int q = tid >> 2, qt = tid & 3;
                  const bf16_t* vp = Z + (size_t)(R0 + q) * EV_IN + 4096 + h * 512 + qt * 128;
                  u32x4 vv[16]; float ss = 0.f;
#pragma unroll
                  for (int i = 0; i < 16; ++i) { vv[i] = *(const u32x4*)(vp + i * 8);
                      const float a0 = bf_lo(vv[i].x), a1 = bf_hi(vv[i].x), a2 = bf_lo(vv[i].y), a3 = bf_hi(vv[i].y), a4 = bf_lo(vv[i].z), a5 = bf_hi(vv[i].z), a6 = bf_lo(vv[i].w), a7 = bf_hi(vv[i].w);
                      ss += (a0 * a0 + a1 * a1) + (a2 * a2 + a3 * a3) + (a4 * a4 + a5 * a5) + (a6 * a6 + a7 * a7); }
                  ss += __shfl_xor(ss, 1); ss += __shfl_xor(ss, 2);
                  const float rstd = 1.0f / sqrtf(ss * (1.0f / 512.0f) + EPS);
                  const float* ng = args.in[I_SGUNG] + h * 512 + qt * 128;
                  LAS unsigned char* tile = L + (qt * 2 + (q >> 6)) * 16384;
#pragma unroll
                  for (int i = 0; i < 16; ++i) { const f32x4 g0 = *(const f32x4*)(ng + i * 8), g1 = *(const f32x4*)(ng + i * 8 + 4);
                      u32x4 o; o.x = cvt_pk_bf16(bf_lo(vv[i].x) * rstd * g0.x, bf_hi(vv[i].x) * rstd * g0.y); o.y = cvt_pk_bf16(bf_lo(vv[i].y) * rstd * g0.z, bf_hi(vv[i].y) * rstd * g0.w);
                      o.z = cvt_pk_bf16(bf_lo(vv[i].z) * rstd * g1.x, bf_hi(vv[i].z) * rstd * g1.y); o.w = cvt_pk_bf16(bf_lo(vv[i].w) * rstd * g1.z, bf_hi(vv[i].w) * rstd * g1.w);
                      *(LAS u32x4*)(tile + att::v_st(q & 63, i * 8)) = o; } }
                __syncthreads();
                const float* bsp = args.in[I_SGUB] + h * 128 + 32 * wp;
#pragma unroll
                for (int dbi = 0; dbi < 2; ++dbi) {
                    const int db = 2 * wd + dbi;
                    const float bb = bsp[r32]; const size_t ro = (size_t)(R0 + 32 * wp + r32);
                    const bf16_t* up = Z + ro * EV_IN + 2048 + h * 512 + db * 128 + 4 * hl; bf16_t* yp = YC + ro * D + 2048 + h * 512 + db * 128 + 4 * hl;
                    u32x2 uu[4][4];
#pragma unroll
                    for (int d0 = 0; d0 < 4; ++d0)
#pragma unroll
                        for (int g = 0; g < 4; ++g) uu[d0][g] = *(const u32x2*)(up + d0 * 32 + 8 * g);
                    f32x16 o[4] = {};
                    const int vb = (int)(uintptr_t)(lds + (db * 2) * 16384) + att::v_rd_base(lane);
                    att::pvT_d0(o, vb, pa[0], pa[1], pa[2], pa[3]);
                    att::pvT_d0(o, vb + 16384, pa[4], pa[5], pa[6], pa[7]);
                    asm volatile("" ::: "memory");
#pragma unroll
                    for (int d0 = 0; d0 < 4; ++d0)
#pragma unroll
                        for (int g = 0; g < 4; ++g) { const u32x2 u2 = uu[d0][g];
                            u32x2 w; w.x = cvt_pk_bf16(bf_lo(u2.x) * (o[d0][4 * g + 0] + bb), bf_hi(u2.x) * (o[d0][4 * g + 1] + bb)); w.y = cvt_pk_bf16(bf_lo(u2.y) * (o[d0][4 * g + 2] + bb), bf_hi(u2.y) * (o[d0][4 * g + 3] + bb));
                            *(u32x2*)(yp + d0 * 32 + 8 * g) = w; }
                }
                __syncthreads();
            }
        }
    }
    SEAM(3);

    if (IN(4)) {
        pg8::Gemm g{PA, W_POOL, 2048, 512, 512, 1, 512}; pg8::OrderAll S{8, G, bx}; pg8::EpiPool E{YC, D, args.in[I_POOLS]};
        pg8::gemm_phase(L, g, S, E, wave);
    }
    SEAM(4);

    if (IN(5)) {
        pg8::Gemm g{YC, W_EVOUT, D, D, D, 30, 0}; pg8::OrderXSplitCtx<8> S{G, bx, D / 64}; pg8::EpiResGate E{X, args.in[I_X], args.in[I_CTX], MOD + 2 * D, true, XB, PART};
        pg8::gemm_phase(L, g, S, E, wave);
    }
    SEAM(5);

    if (IN(6)) { const int tid = launder_tid(wave), lane = tid & 63; (void)tid; (void)lane; norm_coop_x(XB, H, args.in[I_N2G], MOD + 3 * D, vcu, G, wave, (LAS float*)L); NORM_CTX_COMBINE(0, 1, true, MOD + (size_t)8 * MODW + 2 * D, true); }
    SEAM(6);

    if (IN(7)) {
        if (bx < G - NH_P7) { pg8::Gemm g{H, (const bf16_t*)(ws + WS_WGU), D, D, D, 30, 0}; pg8::OrderAll S{FFN2 / 256, G - NH_P7, bx}; pg8::EpiSwiGLU E{HID, FFH};
            pg8::gemm_phase(L, g, S, E, wave);
            if (threadIdx.x == 0) __hip_atomic_fetch_add(ctl + CW_HDONE, 1u, __ATOMIC_RELAXED, __HIP_MEMORY_SCOPE_AGENT); }
        else { conv_range(cc, CV_P7_LO, CV_P7_HI, bx - (G - NH_P7), NH_P7, wave, L);
               conv_range<true>(cc, CV_OPT_LO, CV_OPT_HI, bx - (G - NH_P7), NH_P7, wave, L, ctl + CW_HDONE, (unsigned)(G - NH_P7), (int*)(ctl + CW_HSTOP) + (bx - (G - NH_P7)) * 8 + wave); }
    }
    SEAM(7);

    if (IN(8)) {
        pg8::Gemm g{HID, (const bf16_t*)(ws + WS_WDOWN), FFH, FFH, FFH, 30, 0}; pg8::OrderXSplitCtx<2> S{G, bx, FFH / 64};     pg8::EpiResGate E{X, nullptr, nullptr, MOD + 5 * D, false, XB, PART};
        pg8::gemm_phase(L, g, S, E, wave);
    }
    SEAM(8);

    if (IN(9)) { const int tid = launder_tid(wave), lane = tid & 63; (void)tid; (void)lane; norm_coop_x(XB, H, args.in[I_N1G] + D, MOD + (size_t)9 * MODW, vcu, G, wave, (LAS float*)L); NORM_CTX_COMBINE(1, 0, false, MOD + (size_t)8 * MODW + 5 * D, false); }
    SEAM(9);

    if (IN(10)) {
        pg8::Gemm g{H, W_ODIN, D, D, D, 30, 0}; pg8::OrderOdIn S{G, bx}; pg8::EpiBf16 E{Z, ODIN_P, 1 << 30};
        pg8::gemm_phase(L, g, S, E, wave);
    }
    SEAM(10);

    if (IN(11)) { const int tid = launder_tid(wave), lane = tid & 63; (void)tid;
        const float* cosG = ROPEG; const float* sinG = ROPEG + 2048 * 64; const float* cosM = ROPEM; const float* sinM = ROPEM + 2048 * 32;
        const int hh = lane >> 4, jj = lane & 15;
        float gqa[16]; { const float* gp = args.in[I_QAG] + lane * 16;
#pragma unroll
            for (int e = 0; e < 16; ++e) gqa[e] = gp[e]; }
        float gkva[8]; { const float* gp = args.in[I_KVAG] + lane * 8;
#pragma unroll
            for (int e = 0; e < 8; ++e) gkva[e] = gp[e]; }
        const f32x4 gq1 = *(const f32x4*)(args.in[I_QNG] + 4 * jj), gq2 = *(const f32x4*)(args.in[I_QNG] + 64 + 4 * jj);
        const f32x4 gk1 = *(const f32x4*)(args.in[I_KNG] + 4 * jj), gk2 = *(const f32x4*)(args.in[I_KNG] + 64 + 4 * jj);
        for (int R = gw; R < MALL; R += NGW) {
            const int j = R % LT; const bool isx = j >= CTXL; const int t = isx ? j - CTXL : 0;
            bf16_t* zr = Z + (size_t)R * ODIN_P;
            u32x4 cq0 = (u32x4){0u, 0u, 0u, 0u}, cq1 = cq0; u32x2 qa[4], qb[4];
            if (isx) { cq0 = *(const u32x4*)(zr + OC_CQ + lane * 16); cq1 = *(const u32x4*)(zr + OC_CQ + lane * 16 + 8);
#pragma unroll
                for (int it = 0; it < 4; ++it) { const bf16_t* hp = zr + OC_GQ + (it * 4 + hh) * 128 + 4 * jj; qa[it] = *(const u32x2*)hp; qb[it] = *(const u32x2*)(hp + 64); } }
            const u32x4 ckv = *(const u32x4*)(zr + OC_CKV + lane * 8);
            bf16_t* kp_ = zr + OC_GK + hh * 128 + 4 * jj;
            const u32x2 ka = *(const u32x2*)kp_, kb = *(const u32x2*)(kp_ + 64);
            f32x4 cs = (f32x4){1.f, 1.f, 1.f, 1.f}, sn = (f32x4){0.f, 0.f, 0.f, 0.f};
            if (isx) { cs = *(const f32x4*)(cosG + t * 64 + 4 * jj); sn = *(const f32x4*)(sinG + t * 64 + 4 * jj); }
            bf16_t* krp = zr + OC_KR; float kr1 = 0.f, kr2 = 0.f, kcs = 1.f, ksn = 0.f;
            if (isx && lane < 32) { kr1 = bf2f(krp[lane]); kr2 = bf2f(krp[lane + 32]); kcs = cosM[t * 32 + lane]; ksn = sinM[t * 32 + lane]; }
            if (isx) {
                { float f[16] = {bf_lo(cq0.x), bf_hi(cq0.x), bf_lo(cq0.y), bf_hi(cq0.y), bf_lo(cq0.z), bf_hi(cq0.z), bf_lo(cq0.w), bf_hi(cq0.w), bf_lo(cq1.x), bf_hi(cq1.x), bf_lo(cq1.y), bf_hi(cq1.y), bf_lo(cq1.z), bf_hi(cq1.z), bf_lo(cq1.w), bf_hi(cq1.w)};
                  float ss = 0.f;
#pragma unroll
                  for (int e = 0; e < 16; ++e) ss += f[e] * f[e];
                  const float rstd = 1.0f / sqrtf(wave_sum(ss) * (1.0f / 1024.0f) + EPS);
#pragma unroll
                  for (int e = 0; e < 16; ++e) f[e] = f[e] * rstd * gqa[e];
                  u32x4 o0, o1; o0.x = cvt_pk_bf16(f[0], f[1]); o0.y = cvt_pk_bf16(f[2], f[3]); o0.z = cvt_pk_bf16(f[4], f[5]); o0.w = cvt_pk_bf16(f[6], f[7]);
                  o1.x = cvt_pk_bf16(f[8], f[9]); o1.y = cvt_pk_bf16(f[10], f[11]); o1.z = cvt_pk_bf16(f[12], f[13]); o1.w = cvt_pk_bf16(f[14], f[15]);
                  *(u32x4*)(zr + OC_CQ + lane * 16) = o0; *(u32x4*)(zr + OC_CQ + lane * 16 + 8) = o1; }
#pragma unroll
                for (int it = 0; it < 4; ++it) { bf16_t* hp = zr + OC_GQ + (it * 4 + hh) * 128 + 4 * jj;
                    const float x1[4] = {bf_lo(qa[it].x), bf_hi(qa[it].x), bf_lo(qa[it].y), bf_hi(qa[it].y)}, x2[4] = {bf_lo(qb[it].x), bf_hi(qb[it].x), bf_lo(qb[it].y), bf_hi(qb[it].y)};
                    float ss = 0.f;
#pragma unroll
                    for (int e = 0; e < 4; ++e) ss += x1[e] * x1[e] + x2[e] * x2[e];
                    ss += __shfl_xor(ss, 1); ss += __shfl_xor(ss, 2); ss += __shfl_xor(ss, 4); ss += __shfl_xor(ss, 8);
                    const float rstd = 1.0f / sqrtf(ss * (1.0f / 128.0f) + EPS);
                    float y1[4], y2[4];
#pragma unroll
                    for (int e = 0; e < 4; ++e) { const float a1 = x1[e] * rstd * gq1[e], a2 = x2[e] * rstd * gq2[e]; y1[e] = a1 * cs[e] - a2 * sn[e]; y2[e] = a1 * sn[e] + a2 * cs[e]; }
                    u32x2 o1, o2; o1.x = cvt_pk_bf16(y1[0], y1[1]); o1.y = cvt_pk_bf16(y1[2], y1[3]); o2.x = cvt_pk_bf16(y2[0], y2[1]); o2.y = cvt_pk_bf16(y2[2], y2[3]);
                    *(u32x2*)hp = o1; *(u32x2*)(hp + 64) = o2; }
            }
            { float f[8] = {bf_lo(ckv.x), bf_hi(ckv.x), bf_lo(ckv.y), bf_hi(ckv.y), bf_lo(ckv.z), bf_hi(ckv.z), bf_lo(ckv.w), bf_hi(ckv.w)};
              float ss = 0.f;
#pragma unroll
              for (int e = 0; e < 8; ++e) ss += f[e] * f[e];
              const float rstd = 1.0f / sqrtf(wave_sum(ss) * (1.0f / 512.0f) + EPS);
#pragma unroll
              for (int e = 0; e < 8; ++e) f[e] = f[e] * rstd * gkva[e];
              u32x4 o; o.x = cvt_pk_bf16(f[0], f[1]); o.y = cvt_pk_bf16(f[2], f[3]); o.z = cvt_pk_bf16(f[4], f[5]); o.w = cvt_pk_bf16(f[6], f[7]);
              *(u32x4*)(zr + OC_CKV + lane * 8) = o; }
            { const float x1[4] = {bf_lo(ka.x), bf_hi(ka.x), bf_lo(ka.y), bf_hi(ka.y)}, x2[4] = {bf_lo(kb.x), bf_hi(kb.x), bf_lo(kb.y), bf_hi(kb.y)};
              float ss = 0.f;
#pragma unroll
              for (int e = 0; e < 4; ++e) ss += x1[e] * x1[e] + x2[e] * x2[e];
              ss += __shfl_xor(ss, 1); ss += __shfl_xor(ss, 2); ss += __shfl_xor(ss, 4); ss += __shfl_xor(ss, 8);
              const float rstd = 1.0f / sqrtf(ss * (1.0f / 128.0f) + EPS);
              float y1[4], y2[4];
#pragma unroll
              for (int e = 0; e < 4; ++e) { const float a1 = x1[e] * rstd * gk1[e], a2 = x2[e] * rstd * gk2[e]; y1[e] = a1 * cs[e] - a2 * sn[e]; y2[e] = a1 * sn[e] + a2 * cs[e]; }
              u32x2 o1, o2; o1.x = cvt_pk_bf16(y1[0], y1[1]); o1.y = cvt_pk_bf16(y1[2], y1[3]); o2.x = cvt_pk_bf16(y2[0], y2[1]); o2.y = cvt_pk_bf16(y2[2], y2[3]);
              *(u32x2*)kp_ = o1; *(u32x2*)(kp_ + 64) = o2; }
            if (isx && lane < 32) { krp[lane] = f2bf(kr1 * kcs - kr2 * ksn); krp[lane + 32] = f2bf(kr1 * ksn + kr2 * kcs); }
        }
    }
    SEAM(11);

    if (IN(12)) {
        { pg8::Gemm g{Z + OC_CQ, W_QB, ODIN_P, 1024, 1024, 30, 0}; pg8::OrderX<> S{QMW / 256, G, bx}; pg8::EpiBf16 E{QM, QMW, 1 << 30};
          pg8::gemm_phase(L, g, S, E, wave); }
        { pg8::Gemm g{Z + OC_CKV, W_KVB, ODIN_P, 512, 512, 30, 0}; pg8::OrderAll S{KVW / 256, G, bx}; pg8::EpiBf16 E{KVM, KVW, 1 << 30};
          pg8::gemm_phase(L, g, S, E, wave); }
    }
    SEAM(12);


    if (IN(14)) {
        const int xg = bx & 7, kk = bx >> 3;
        const int nper = G >> 3;
        for (int i = 0; ; ++i) {
            const int un = (i * 8 + xg) * nper + kk; if (un >= 1024) break;
            const int bh = un >> 3, qb = un & 7, b = bh >> 4, h = bh & 15;
            const size_t krow0 = (size_t)b * LT, qrow0 = krow0 + CTXL + (size_t)qb * 256;
            att::attn_body<192, MLA_SDEPTH, QMW, KVW, ODIN_P, KVW, D>(QM + qrow0 * QMW + h * 192, KVM + krow0 * KVW + h * 256, Z + krow0 * ODIN_P + OC_KR, KVM + krow0 * KVW + h * 256 + 128,
                                                           YC + qrow0 * D + h * 128, LT, 0.07216878364870322f, (char*)lds, wave, ROPEM + (size_t)qb * 256 * 32, ROPEM + 2048 * 32 + (size_t)qb * 256 * 32);
        }
        for (int i = 0; ; ++i) {
            const int un = (i * 8 + xg) * nper + kk; if (un >= 1024) break;
            const int grp = un >> 5, r = un & 31, b = grp >> 2, kvh = grp & 3, h = kvh * 4 + (r >> 3), qb = r & 7;
            const size_t krow0 = (size_t)b * LT, qrow0 = krow0 + CTXL + (size_t)qb * 256;
            att::attn_body<128, GQA_SDEPTH, ODIN_P, ODIN_P, ODIN_P, ODIN_P, D>(Z + qrow0 * ODIN_P + OC_GQ + h * 128, Z + krow0 * ODIN_P + OC_GK + kvh * 128, nullptr, Z + krow0 * ODIN_P + OC_GV + kvh * 128,
                                                                   YC + qrow0 * D + 2048 + h * 128, LT, 0.08838834764831845f, (char*)lds, wave);
        }
    }
    SEAM(14);

    if (IN(15)) {
        pg8::Gemm g{YC, W_ODOUT, D, D, D, 30, 0}; pg8::OrderX<8> S{D / 256, G, bx}; pg8::EpiResGate E{X, nullptr, nullptr, MOD + (size_t)9 * MODW + 2 * D, false, XB, nullptr};
        pg8::gemm_phase(L, g, S, E, wave);
    }
    SEAM(15);

    if (IN(16)) { const int tid = launder_tid(wave), lane = tid & 63; (void)tid; (void)lane; conv_catchup(cc, CV_OPT_HI, NH_P7 * 8, (const int*)(ctl + CW_HSTOP), gw, NGW, wave, L); __syncthreads(); norm_coop_x(XB, H, args.in[I_N2G] + D, MOD + (size_t)9 * MODW + 3 * D, vcu, G, wave, (LAS float*)L); }
    SEAM(16);

    if (IN(17)) {
        if (bx < G - NH_P17) { pg8::Gemm g{H, (const bf16_t*)(ws + WS_WGU + WGU_L), D, D, D, 30, 0}; pg8::OrderX<> S{FFN2 / 256, G - NH_P17, bx}; pg8::EpiSwiGLU E{HID, FFH};
            pg8::gemm_phase(L, g, S, E, wave); }
        else conv_range(cc, CV_P17_LO, CV_P17_HI, bx - (G - NH_P17), NH_P17, wave, L);
    }
    SEAM(17);

    if (IN(18)) {
        pg8::Gemm g{HID, (const bf16_t*)(ws + WS_WDOWN + WDOWN_L), FFH, FFH, FFH, 30, 0}; pg8::OrderX<2> S{D / 256, G, bx}; pg8::EpiResGate E{X, nullptr, nullptr, MOD + (size_t)9 * MODW + 5 * D, false, XB, nullptr};
        pg8::gemm_phase(L, g, S, E, wave);
    }
    SEAM(18);

    if (IN(19)) { const int tid = launder_tid(wave), lane = tid & 63; (void)tid; (void)lane;
        const float* gvec = args.in[I_FING];
        for (int idx = gw; idx < NB * SEQ; idx += NGW) {
            const bf16_t* srow = XB + (size_t)xrow(idx) * D; float* orow = args.out + (size_t)idx * D;
            u32x4 v[8]; float ss = 0.f;
#pragma unroll
            for (int q = 0; q < 8; ++q) { v[q] = *(const u32x4*)(srow + (q * 64 + lane) * 8);
                const float a0 = bf_lo(v[q].x), a1 = bf_hi(v[q].x), a2 = bf_lo(v[q].y), a3 = bf_hi(v[q].y), a4 = bf_lo(v[q].z), a5 = bf_hi(v[q].z), a6 = bf_lo(v[q].w), a7 = bf_hi(v[q].w);
                ss += ((a0 * a0 + a1 * a1) + (a2 * a2 + a3 * a3)) + ((a4 * a4 + a5 * a5) + (a6 * a6 + a7 * a7)); }
            const float rstd = 1.0f / sqrtf(wave_sum(ss) * (1.0f / D) + EPS);
#pragma unroll
            for (int q = 0; q < 8; ++q) { const int c = (q * 64 + lane) * 8;
                const f32x4 x0 = (f32x4){bf_lo(v[q].x), bf_hi(v[q].x), bf_lo(v[q].y), bf_hi(v[q].y)}, x1 = (f32x4){bf_lo(v[q].z), bf_hi(v[q].z), bf_lo(v[q].w), bf_hi(v[q].w)};
                *(f32x4*)(orow + c) = x0 * rstd * *(const f32x4*)(gvec + c); *(f32x4*)(orow + c + 4) = x1 * rstd * *(const f32x4*)(gvec + c + 4); }
        }
    }
#undef IN
#undef SEAM
}

extern "C" void kernel_launch(void* const* d_in, const int* in_sizes, int n_in, void* d_out, int out_size, void* d_ws, size_t ws_size, hipStream_t stream) {
    static int grid = 0;
    if (grid == 0) {
        if (n_in != 26 || out_size != NB * SEQ * D || ws_size < WS_END) { fprintf(stderr, "kernel_launch: unexpected shapes: n_in %d out %d ws %zu (need %zu); nothing launched\n", n_in, out_size, ws_size, (size_t)WS_END); grid = -1; return; }
        int dev = 0, cus = 0;
        if (hipGetDevice(&dev) != hipSuccess || hipDeviceGetAttribute(&cus, hipDeviceAttributeMultiprocessorCount, dev) != hipSuccess) { grid = -1; return; }
        if (hipFuncSetAttribute((const void*)trunk_fwd, hipFuncAttributeMaxDynamicSharedMemorySize, LDS_BYTES) != hipSuccess) { fprintf(stderr, "kernel_launch: hipFuncSetAttribute failed\n"); grid = -1; return; }
        int per_cu = 0;
        if (hipOccupancyMaxActiveBlocksPerMultiprocessor(&per_cu, (const void*)trunk_fwd, 512, LDS_BYTES) != hipSuccess || per_cu < 1) fprintf(stderr, "kernel_launch: occupancy query says %d\n", per_cu);
        (void)hipGetLastError();
        grid = cus;
    }
    if (grid < 0) return;
    (void)hipMemsetAsync((char*)d_ws + WS_CTL, 0, CTL_BYTES, stream);
    Args a{};
    for (int i = 0; i < 26; ++i) a.in[i] = (const float*)d_in[i];
    a.out = (float*)d_out; a.ws = (unsigned char*)d_ws;
#if MK_N_LAUNCHES == 1
    a.ph_lo = 0; a.ph_hi = N_PHASES;
    hipLaunchKernelGGL(trunk_fwd, dim3(grid), dim3(512), LDS_BYTES, stream, a);
#else
    for (int p = 0; p < N_PHASES; ++p) { a.ph_lo = p; a.ph_hi = p + 1; hipLaunchKernelGGL(trunk_fwd, dim3(grid), dim3(512), LDS_BYTES, stream, a); }
#endif
    const hipError_t le = hipPeekAtLastError();
    if (le != hipSuccess) fprintf(stderr, "kernel_launch: launch failed: %s\n", hipGetErrorName(le));
}
```
